# Optimizing an MI355X kernel written in HIP

```python
import functools
import jax, jax.numpy as jnp
from jax import lax
import numpy as np

D_MODEL = 1024
BATCH = 16
SEQ = 2048
DEPTH = 4

GRID_W = 64
CTX_LEN = 256
N_MIXERS = 2
N_A = (DEPTH + 1) // 2
N_B = DEPTH // 2
N_MOD = 9
D_FF = 2816
CONV_DIM = D_MODEL
CONV_W = 3
MLA_HEADS = 8
QK_NOPE = 128
QK_ROPE = 64
QK_HEAD = QK_NOPE + QK_ROPE
V_HEAD = 128
Q_LORA = 256
KV_LORA = 128
ROPE_BASE = 10000.0
QK_SCALE = QK_HEAD ** -0.5
Q_BLOCK = 128
EPS = 1e-6

kernel_name = "hybrid_shortconv_mla_macaron_dit"


def rms_norm(x, g):
    xf = x.astype(jnp.float32)
    y = xf * lax.rsqrt(jnp.mean(xf * xf, axis=-1, keepdims=True) + EPS)
    return (y * g.astype(jnp.float32)).astype(x.dtype)


def adaln_chunks(cond, w_mod, b_mod):
    m = jax.nn.silu(cond) @ w_mod + b_mod
    return jnp.split(m[:, None, :], N_MOD, axis=-1)


def pre(h, g, shift, scale):
    return rms_norm(h, g) * (1 + scale) + shift


def swiglu(h, w1, w3, w2):
    return (jax.nn.silu(h @ w1) * (h @ w3)) @ w2


def conv3_centred(u, w):
    return lax.conv_general_dilated(
        u, w[:, None, :].astype(u.dtype), window_strides=(1,), padding=((1, 1),),
        dimension_numbers=("NWC", "WIO", "NWC"), feature_group_count=u.shape[-1])


def short_conv_mixer(h, w_in, conv_w, w_out):
    b_gate, c_gate, u = jnp.split(h @ w_in, 3, axis=-1)
    return (b_gate * conv3_centred(c_gate * u, conv_w)) @ w_out


def axial_rope_tables(n):
    rows = n // GRID_W
    r = jnp.broadcast_to(jnp.arange(rows)[:, None], (rows, GRID_W)).reshape(n).astype(jnp.float32)
    col = jnp.broadcast_to(jnp.arange(GRID_W)[None, :], (rows, GRID_W)).reshape(n).astype(jnp.float32)
    n_freq = QK_ROPE // 4
    inv = ROPE_BASE ** (-jnp.arange(n_freq, dtype=jnp.float32) / n_freq)
    ang = jnp.stack([r[:, None] * inv, col[:, None] * inv], axis=1)
    return jnp.cos(ang), jnp.sin(ang)


def apply_axial_rope(t, cos, sin):
    ts = t.reshape(t.shape[:-1] + (2, 2, QK_ROPE // 4))
    x1, x2 = ts[..., 0, :], ts[..., 1, :]
    cos = cos.astype(t.dtype)
    sin = sin.astype(t.dtype)
    y = jnp.stack([x1 * cos - x2 * sin, x1 * sin + x2 * cos], axis=-2)
    return y.reshape(t.shape)


def rope_tail(t, cos, sin):
    return jnp.concatenate([t[..., :QK_NOPE], apply_axial_rope(t[..., QK_NOPE:], cos, sin)], axis=-1)


def mla_down(h, w_a):
    return jnp.split(h @ w_a, [Q_LORA, Q_LORA + KV_LORA], axis=-1)


def mla_queries(cq, g_qa, w_uq, g_q):
    b, n, _ = cq.shape
    q = (rms_norm(cq, g_qa) @ w_uq).reshape(b, n, MLA_HEADS, QK_HEAD)
    return rms_norm(q, g_q).transpose(0, 2, 1, 3)


def mla_keys_values(ckv, k_rope, g_kva, w_ukv, g_k):
    b, n, _ = ckv.shape
    kv = (rms_norm(ckv, g_kva) @ w_ukv).reshape(b, n, MLA_HEADS, QK_NOPE + V_HEAD)
    k_nope, v = jnp.split(kv, [QK_NOPE], axis=-1)
    k_r = jnp.broadcast_to(k_rope[:, :, None, :], (b, n, MLA_HEADS, QK_ROPE))
    k = rms_norm(jnp.concatenate([k_nope, k_r], axis=-1), g_k)
    return k.transpose(0, 2, 1, 3), v.transpose(0, 2, 1, 3)


def softmax_attend(q, k, v):
    s = jnp.einsum("bhqd,bhkd->bhqk", q, k).astype(jnp.float32) * QK_SCALE
    p = jax.nn.softmax(s, axis=-1).astype(v.dtype)
    return jnp.einsum("bhqk,bhkd->bhqd", p, v)


def merge_heads(o):
    b, h, n, d = o.shape
    return o.transpose(0, 2, 1, 3).reshape(b, n, h * d)


def latent_attention(q, k_all, v_all):
    b, h, n, dq = q.shape
    nb = n // Q_BLOCK
    qb = q.reshape(b, h, nb, Q_BLOCK, dq).transpose(2, 0, 1, 3, 4)
    o = lax.map(lambda qblk: softmax_attend(qblk, k_all, v_all), qb)
    return o.transpose(1, 0, 3, 2, 4).reshape(b, n, h * V_HEAD)


def setup_inputs(seed: int = 0) -> dict:
    key = jax.random.key(seed)
    ks = jax.random.split(key, 24)
    f32 = jnp.float32

    def nrm(k, shape, scale):
        return jax.random.normal(k, shape, f32) * scale

    def gain(k, shape):
        return 1.0 + 0.1 * jax.random.normal(k, shape, f32)

    D = D_MODEL
    return {
        "x": nrm(ks[0], (BATCH, SEQ, D), 1.0),
        "c": nrm(ks[1], (BATCH, D), 1.0),
        "ctx": nrm(ks[2], (BATCH, CTX_LEN, D), 1.0),
        "c_ctx": nrm(ks[3], (D,), 1.0),
        "w_mod": nrm(ks[4], (DEPTH, D, N_MOD * D), 0.5 * D ** -0.5),
        "b_mod": nrm(ks[5], (DEPTH, N_MOD * D), 0.02),
        "g_norm": gain(ks[6], (DEPTH, 3, D)),
        "ffn_w1": nrm(ks[7], (DEPTH, 2, D, D_FF), D ** -0.5),
        "ffn_w3": nrm(ks[8], (DEPTH, 2, D, D_FF), D ** -0.5),
        "ffn_w2": nrm(ks[9], (DEPTH, 2, D_FF, D), D_FF ** -0.5),
        "sc_w_in": nrm(ks[10], (N_A, D, 3 * CONV_DIM), D ** -0.5),
        "sc_conv": nrm(ks[11], (N_A, CONV_W, CONV_DIM), CONV_W ** -0.5),
        "sc_w_out": nrm(ks[12], (N_A, CONV_DIM, D), CONV_DIM ** -0.5),
        "mla_w_a": nrm(ks[13], (N_B, D, Q_LORA + KV_LORA + QK_ROPE), D ** -0.5),
        "mla_g_qa": gain(ks[14], (N_B, Q_LORA)),
        "mla_w_uq": nrm(ks[15], (N_B, Q_LORA, MLA_HEADS * QK_HEAD), Q_LORA ** -0.5),
        "mla_g_kva": gain(ks[16], (N_B, KV_LORA)),
        "mla_w_ukv": nrm(ks[17], (N_B, KV_LORA, MLA_HEADS * (QK_NOPE + V_HEAD)), KV_LORA ** -0.5),
        "mla_g_q": gain(ks[18], (N_B, QK_HEAD)),
        "mla_g_k": gain(ks[19], (N_B, QK_HEAD)),
        "mla_w_o": nrm(ks[20], (N_B, MLA_HEADS * V_HEAD, D), (MLA_HEADS * V_HEAD) ** -0.5),
    }


def reference(x, c, ctx, c_ctx, w_mod, b_mod, g_norm, ffn_w1, ffn_w3, ffn_w2,
              sc_w_in, sc_conv, sc_w_out, mla_w_a, mla_g_qa, mla_w_uq, mla_g_kva,
              mla_w_ukv, mla_g_q, mla_g_k, mla_w_o):
    n = x.shape[1]
    cos, sin = axial_rope_tables(n)
    h_x, h_c = x, ctx
    for i in range(DEPTH):
        kind, j = i % N_MIXERS, i // N_MIXERS
        last = i == DEPTH - 1
        run_ctx_in = (not last) or kind == 1
        run_ctx_out = not last

        mx = adaln_chunks(c, w_mod[i], b_mod[i])
        mc = adaln_chunks(c_ctx[None], w_mod[i], b_mod[i])
        ffn1 = functools.partial(swiglu, w1=ffn_w1[i, 0], w3=ffn_w3[i, 0], w2=ffn_w2[i, 0])
        ffn2 = functools.partial(swiglu, w1=ffn_w1[i, 1], w3=ffn_w3[i, 1], w2=ffn_w2[i, 1])

        h_x = h_x + 0.5 * mx[2] * ffn1(pre(h_x, g_norm[i, 0], mx[0], mx[1]))
        if run_ctx_in:
            h_c = h_c + 0.5 * mc[2] * ffn1(pre(h_c, g_norm[i, 0], mc[0], mc[1]))

        nx = pre(h_x, g_norm[i, 1], mx[3], mx[4])
        if kind == 0:
            ox = short_conv_mixer(nx, sc_w_in[j], sc_conv[j], sc_w_out[j])
            if run_ctx_out:
                nc = pre(h_c, g_norm[i, 1], mc[3], mc[4])
                oc = short_conv_mixer(nc, sc_w_in[j], sc_conv[j], sc_w_out[j])
        else:
            nc = pre(h_c, g_norm[i, 1], mc[3], mc[4])
            cq_c, ckv_c, kr_c = mla_down(nc, mla_w_a[j])
            k_c, v_c = mla_keys_values(ckv_c, kr_c, mla_g_kva[j], mla_w_ukv[j], mla_g_k[j])
            cq_x, ckv_x, kr_x = mla_down(nx, mla_w_a[j])
            k_x, v_x = mla_keys_values(ckv_x, kr_x, mla_g_kva[j], mla_w_ukv[j], mla_g_k[j])
            k_x = rope_tail(k_x, cos, sin)
            q_x = rope_tail(mla_queries(cq_x, mla_g_qa[j], mla_w_uq[j], mla_g_q[j]), cos, sin)
            k_all = jnp.concatenate([k_c, k_x], axis=2)
            v_all = jnp.concatenate([v_c, v_x], axis=2)
            ox = latent_attention(q_x, k_all, v_all) @ mla_w_o[j]
            if run_ctx_out:
                q_c = mla_queries(cq_c, mla_g_qa[j], mla_w_uq[j], mla_g_q[j])
                oc = merge_heads(softmax_attend(q_c, k_c, v_c)) @ mla_w_o[j]
        h_x = h_x + mx[5] * ox
        if run_ctx_out:
            h_c = h_c + mc[5] * oc

        h_x = h_x + 0.5 * mx[8] * ffn2(pre(h_x, g_norm[i, 2], mx[6], mx[7]))
        if run_ctx_out:
            h_c = h_c + 0.5 * mc[8] * ffn2(pre(h_c, g_norm[i, 2], mc[6], mc[7]))
    return h_x
```

```cpp
#include <hip/hip_runtime.h>
#include <hip/hip_cooperative_groups.h>
#include <cstdio>
#include <cstdint>
namespace cg = cooperative_groups;
namespace pg8 {
#define PG8_LAS __attribute__((address_space(3)))
typedef unsigned short bf16_t;
typedef short bf16x8 __attribute__((ext_vector_type(8)));
typedef float f32x4 __attribute__((ext_vector_type(4)));
typedef unsigned u32x4 __attribute__((ext_vector_type(4)));
typedef unsigned u32x2 __attribute__((ext_vector_type(2)));
constexpr int BM = 256, BK = 64, HALF = 128, HTB = HALF * BK * 2  , STAGE_BYTES = 8 * HTB, NXCD = 8, WGM = 8;

__device__ __forceinline__ float xrow_sum(float v) {
    { auto r_ = __builtin_amdgcn_permlane16_swap(__float_as_uint(v), __float_as_uint(v), false, false); v = __uint_as_float(r_[0]) + __uint_as_float(r_[1]); }
    { auto r_ = __builtin_amdgcn_permlane32_swap(__float_as_uint(v), __float_as_uint(v), false, false); v = __uint_as_float(r_[0]) + __uint_as_float(r_[1]); }
    return v;
}
__host__ __device__ __forceinline__ int lds_byte(int r, int c) { const int st = (r >> 4) * 2 + (c >> 5), rr = r & 15, cc = c & 31, ob = rr * 64 + cc * 2; return st * 1024 + (ob ^ (((ob >> 9) & 1) << 5)); }
__host__ __device__ __forceinline__ void stage_rc(int b, int& R, int& C) { const int st = b / 1024, sb = b % 1024, swz = sb ^ (((sb >> 9) & 1) << 5); R = (st >> 1) * 16 + swz / 64; C = (st & 1) * 32 + (swz % 64) / 2; }
__host__ __device__ __forceinline__ int perm32(int rho) { const int n = rho >> 4, i = rho & 15; return 8 * (i >> 2) + 4 * n + (i & 3); }

struct Unit { int pm, pn, k0, nt; };
template <int N_, int K_, int LDA_> struct GemmT { const bf16_t* A; const bf16_t* Bt; int M; static constexpr int N = N_, K = K_, lda = LDA_; };

struct StaticOrder {
    int nM, nN, nwg, G, c;
    __host__ __device__ void init(int M, int N, int G_, int c_) { nM = M / BM; nN = N / BM; nwg = nM * nN; G = G_; c = c_; }
    __host__ __device__ bool next(int i, Unit& u) const {
        const long L = (long)i * G + c; if (L >= nwg) return false;
        int wgid = (int)L; { const int q = nwg / NXCD, r = nwg % NXCD, xcd = wgid % NXCD, off = wgid / NXCD; wgid = (xcd < r ? xcd * (q + 1) : r * (q + 1) + (xcd - r) * q) + off; }
        const int nig = WGM * nN, gid = wgid / nig, fm = gid * WGM, gsz = (nM - fm) < WGM ? (nM - fm) : WGM;
        u.pm = fm + ((wgid % nig) % gsz); u.pn = (wgid % nig) / gsz; u.k0 = 0; u.nt = 0; return true;
    }
    __device__ __forceinline__ void a_ready(const Unit&) const {}
    __device__ __forceinline__ void done(const Unit&) const {}
};


struct SplitCtxOrder {
    StaticOrder lat; int c, ntf;
    __host__ __device__ void init(int Mlat, int N, int G_, int c_, int ntf_) { lat.init(Mlat, N, G_, c_); c = c_; ntf = ntf_; }
    __host__ __device__ bool next(int i, Unit& u) const {
        if (i < 2) return lat.next(i, u);
        if (i > 2) return false;
        const int cu = c >> 2, kq = c & 3, base = ntf >> 2, odd = base & 1;
        u.pm = 128 + (cu >> 2); u.pn = cu & 3;
        u.k0 = kq * base + (odd ? (kq & 1) : 0); u.nt = base + (odd ? ((kq & 1) ? -1 : 1) : 0);
        return true;
    }
    __device__ __forceinline__ void a_ready(const Unit&) const {}
    __device__ __forceinline__ void done(const Unit&) const {}
};
__device__ __forceinline__ unsigned cvt_pk_bf16(float lo, float hi) { unsigned r; asm volatile("v_cvt_pk_bf16_f32 %0, %1, %2" : "=v"(r) : "v"(lo), "v"(hi)); return r; }
__device__ __forceinline__ u32x4 pack8(const f32x4 v0, const f32x4 v1) { u32x4 w; w.x = cvt_pk_bf16(v0[0], v0[1]); w.y = cvt_pk_bf16(v0[2], v0[3]); w.z = cvt_pk_bf16(v1[0], v1[1]); w.w = cvt_pk_bf16(v1[2], v1[3]); return w; }
__device__ __forceinline__ float silu_f(float a) { return a * __builtin_amdgcn_rcpf(1.0f + __builtin_amdgcn_exp2f(-1.4426950408889634f * a)); }

#define PG8_GAS __attribute__((address_space(1)))
constexpr int RL_ROWS = 32768;
__device__ __forceinline__ float row_rs(const float* ssp, int row) { const PG8_GAS f32x4* p = (const PG8_GAS f32x4*)(ssp + (size_t)row * 16); const f32x4 a = p[0], b = p[1], c = p[2], d = p[3];
    const float s = ((a[0] + a[1]) + (a[2] + a[3])) + ((b[0] + b[1]) + (b[2] + b[3])) + (((c[0] + c[1]) + (c[2] + c[3])) + ((d[0] + d[1]) + (d[2] + d[3]))); return rsqrtf(s * (1.0f / 1024.0f) + 1e-6f); }

constexpr int RS_LDS_OFF = 131072;
__device__ __forceinline__ void tile_rs_build(const float* ss, int rowt, int wr, int wc, int fr, int fq) {
    const int t = (wr * 4 + wc) * 64 + fq * 16 + fr;
    if (t < 256) ((PG8_LAS float*)(uintptr_t)RS_LDS_OFF)[t] = row_rs(ss, rowt + t);
    asm volatile("s_waitcnt lgkmcnt(0)" ::: "memory"); __builtin_amdgcn_s_barrier(); asm volatile("" ::: "memory");
}
__device__ __forceinline__ float tile_rs(int rloc) { return ((const PG8_LAS float*)(uintptr_t)RS_LDS_OFF)[rloc]; }
struct EpiSwiGLU {
    static constexpr bool PERM = true, AFTER_DRAIN = false;
    bf16_t* O; int ldc; const float* ss; const float* bias;
    __device__ __forceinline__ void operator()(const f32x4 (&acc)[2][2][4][2], const Unit& u, int wr, int wc, int fr, int fq) const {
        const int rowt = u.pm * BM, cond = rowt < RL_ROWS ? (rowt >> 11) : 16;
        const int row0 = rowt + wr * 64 + fr, col0 = u.pn * HALF + wc * 32 + 8 * fq;
        const float* bp = bias + (size_t)cond * (2 * ldc) + u.pn * BM + wc * 32 + 8 * fq;
        f32x4 bv[2][2];
#pragma unroll
        for (int bj = 0; bj < 2; ++bj)
#pragma unroll
            for (int n = 0; n < 2; ++n) bv[bj][n] = *(const f32x4*)(bp + bj * HALF + 4 * n);
        tile_rs_build(ss, rowt, wr, wc, fr, fq);
#pragma unroll
        for (int ai = 0; ai < 2; ++ai)
#pragma unroll
            for (int m = 0; m < 4; ++m) { const int row = row0 + ai * HALF + m * 16; const float rs = tile_rs(row - rowt); bf16_t* rowp = O + (size_t)row * ldc + col0;
                f32x4 v0, v1;
#pragma unroll
                for (int j = 0; j < 4; ++j) { v0[j] = silu_f(acc[ai][0][m][0][j] * rs + bv[0][0][j]) * (acc[ai][1][m][0][j] * rs + bv[1][0][j]); v1[j] = silu_f(acc[ai][0][m][1][j] * rs + bv[0][1][j]) * (acc[ai][1][m][1][j] * rs + bv[1][1][j]); }
                *(PG8_GAS u32x4*)rowp = pack8(v0, v1); }
    }
};
struct EpiBf16 {
    static constexpr bool PERM = true, AFTER_DRAIN = false;
    bf16_t* O; int ldc; const float* rs4; const float* ss; const float* bias; float* sqout;
    __device__ __forceinline__ void operator()(const f32x4 (&acc)[2][2][4][2], const Unit& u, int wr, int wc, int fr, int fq) const {
        const int rowt = u.pm * BM, cond = rowt < RL_ROWS ? (rowt >> 11) : 16;
        const int row0 = rowt + wr * 64 + fr, col0 = u.pn * BM + wc * 32 + 8 * fq;
        f32x4 bv[2][2];
#pragma unroll
        for (int bj = 0; bj < 2; ++bj)
#pragma unroll
            for (int n = 0; n < 2; ++n) bv[bj][n] = bias ? *(const f32x4*)(bias + (size_t)cond * ldc + col0 + bj * HALF + 4 * n) : (f32x4){0.f, 0.f, 0.f, 0.f};
        if (!rs4) tile_rs_build(ss, rowt, wr, wc, fr, fq);
#pragma unroll
        for (int ai = 0; ai < 2; ++ai)
#pragma unroll
            for (int m = 0; m < 4; ++m) { const int row = row0 + ai * HALF + m * 16; float s;
                if (rs4) { const f32x4 p = *(const PG8_GAS f32x4*)(rs4 + (size_t)row * 8); s = rsqrtf(((p[0] + p[1]) + (p[2] + p[3])) * (1.0f / 256.0f) + 1e-6f); } else s = tile_rs(row - rowt);
                bf16_t* rowp = O + (size_t)row * ldc + col0; float sq = 0.f;
#pragma unroll
                for (int bj = 0; bj < 2; ++bj) { const f32x4 v0 = acc[ai][bj][m][0] * s + bv[bj][0], v1 = acc[ai][bj][m][1] * s + bv[bj][1]; *(PG8_GAS u32x4*)(rowp + bj * HALF) = pack8(v0, v1);
                    if (bj == 0 || u.pn == 0) sq += ((v0[0] * v0[0] + v0[1] * v0[1]) + (v0[2] * v0[2] + v0[3] * v0[3])) + ((v1[0] * v1[0] + v1[1] * v1[1]) + (v1[2] * v1[2] + v1[3] * v1[3])); }
                if (sqout) { sq = xrow_sum(sq); if (fq == 0 && u.pn < 2) sqout[(size_t)row * 8 + u.pn * 4 + wc] = sq; } }
    }
};
struct EpiKV {
    static constexpr bool PERM = true, AFTER_DRAIN = false;
    bf16_t* Kb; bf16_t* Vb; const float* rs4;
    __device__ __forceinline__ void operator()(const f32x4 (&acc)[2][2][4][2], const Unit& u, int wr, int wc, int fr, int fq) const {
        const int row0 = u.pm * BM + wr * 64 + fr, c0 = wc * 32 + 8 * fq;
#pragma unroll
        for (int ai = 0; ai < 2; ++ai)
#pragma unroll
            for (int m = 0; m < 4; ++m) { const int row = row0 + ai * HALF + m * 16; const f32x4 p = *(const PG8_GAS f32x4*)(rs4 + (size_t)row * 8 + 4); const float s = rsqrtf(((p[0] + p[1]) + (p[2] + p[3])) * (1.0f / 128.0f) + 1e-6f);
                *(PG8_GAS u32x4*)(Kb + (size_t)row * 1536 + u.pn * 192 + c0) = pack8(acc[ai][0][m][0] * s, acc[ai][0][m][1] * s);
                *(PG8_GAS u32x4*)(Vb + (size_t)row * 1024 + u.pn * 128 + c0) = pack8(acc[ai][1][m][0] * s, acc[ai][1][m][1] * s); }
    }
};
struct EpiWin {
    static constexpr bool PERM = true, AFTER_DRAIN = false;
    bf16_t* Bb; bf16_t* Vb; const float* ss; const float* bias;
    __device__ __forceinline__ void operator()(const f32x4 (&acc)[2][2][4][2], const Unit& u, int wr, int wc, int fr, int fq) const {
        const int rowt = u.pm * BM, cond = rowt < RL_ROWS ? (rowt >> 11) : 16;
        const int row0 = rowt + wr * 64 + fr, c0 = wc * 32 + 8 * fq;
        const float* bp = bias + (size_t)cond * 3072 + u.pn * BM + c0;
        f32x4 bv[2][2];
#pragma unroll
        for (int bj = 0; bj < 2; ++bj)
#pragma unroll
            for (int n = 0; n < 2; ++n) bv[bj][n] = *(const f32x4*)(bp + bj * HALF + 4 * n);
        tile_rs_build(ss, rowt, wr, wc, fr, fq);
        if (u.pn < 4) {
#pragma unroll
            for (int ai = 0; ai < 2; ++ai)
#pragma unroll
                for (int m = 0; m < 4; ++m) { const int row = row0 + ai * HALF + m * 16; const float rs = tile_rs(row - rowt); bf16_t* rowp = Bb + (size_t)row * 1024 + u.pn * BM + c0;
#pragma unroll
                    for (int bj = 0; bj < 2; ++bj) *(PG8_GAS u32x4*)(rowp + bj * HALF) = pack8(acc[ai][bj][m][0] * rs + bv[bj][0], acc[ai][bj][m][1] * rs + bv[bj][1]); }
        } else {
#pragma unroll
            for (int ai = 0; ai < 2; ++ai)
#pragma unroll
                for (int m = 0; m < 4; ++m) { const int row = row0 + ai * HALF + m * 16; const float rs = tile_rs(row - rowt); bf16_t* rowp = Vb + (size_t)row * 1024 + (u.pn - 4) * HALF + c0;
                    *(PG8_GAS u32x4*)rowp = pack8((acc[ai][0][m][0] * rs + bv[0][0]) * (acc[ai][1][m][0] * rs + bv[1][0]), (acc[ai][0][m][1] * rs + bv[0][1]) * (acc[ai][1][m][1] * rs + bv[1][1])); }
        }
    }
};
struct EpiRes {
    static constexpr bool PERM = false, AFTER_DRAIN = false;
    const float* hin_l; const float* hin_c; float* hout_l; float* hout_c; const float* gate;   int half;
    bf16_t* NHn; float* SSn; const float* gn; const float* scn;
    float* part; int kbase;
    __device__ __forceinline__ void operator()(const f32x4 (&acc)[2][2][4][2], const Unit& u, int wr, int wc, int fr, int fq) const {
        if (u.nt != 0) {
            PG8_GAS bf16_t* pp = (PG8_GAS bf16_t*)((bf16_t*)part + ((size_t)(u.k0 / kbase) * 4096 + (size_t)(u.pm * BM - RL_ROWS)) * 1024); const unsigned o0 = (unsigned)((wr * 64 + fr) * 1024 + u.pn * BM + wc * 32 + 4 * fq);
#pragma unroll
            for (int ai = 0; ai < 2; ++ai)
#pragma unroll
                for (int m = 0; m < 4; ++m)
#pragma unroll
                    for (int bj = 0; bj < 2; ++bj)
#pragma unroll
                        for (int n = 0; n < 2; ++n) { const f32x4 a_ = acc[ai][bj][m][n]; u32x2 w_; w_.x = cvt_pk_bf16(a_[0], a_[1]); w_.y = cvt_pk_bf16(a_[2], a_[3]); *(PG8_GAS u32x2*)(pp + o0 + (unsigned)((ai * HALF + m * 16) * 1024 + bj * HALF + n * 16)) = w_; }
            return;
        }
        const int rowt = u.pm * BM; const bool lat = rowt < RL_ROWS; const int cond = lat ? (rowt >> 11) : 16;
        const PG8_GAS float* hi = (const PG8_GAS float*)(lat ? hin_l + (size_t)rowt * 1024 : hin_c + (size_t)(rowt - RL_ROWS) * 1024);
        PG8_GAS float* ho = (PG8_GAS float*)(lat ? hout_l + (size_t)rowt * 1024 : hout_c + (size_t)(rowt - RL_ROWS) * 1024);
        PG8_GAS bf16_t* nht = (PG8_GAS bf16_t*)(NHn + (size_t)rowt * 1024); PG8_GAS float* sst = (PG8_GAS float*)(SSn + (size_t)rowt * 16);
        const int col0 = u.pn * BM + wc * 32 + 4 * fq; const float* gp = gate + (size_t)cond * 9216 + col0;
        f32x4 gv[2][2], gsv[2][2]; const float gs = half ? 0.5f : 1.0f; const bool nxt = gn != nullptr;
#pragma unroll
        for (int bj = 0; bj < 2; ++bj)
#pragma unroll
            for (int n = 0; n < 2; ++n) { gv[bj][n] = *(const f32x4*)(gp + bj * HALF + n * 16) * gs;
                gsv[bj][n] = nxt ? *(const f32x4*)(gn + col0 + bj * HALF + n * 16) * (*(const f32x4*)(scn + (size_t)cond * 9216 + col0 + bj * HALF + n * 16) + 1.0f) : (f32x4){0.f, 0.f, 0.f, 0.f}; }
        const unsigned off0 = (unsigned)((wr * 64 + fr) * 1024 + col0);
#pragma unroll
        for (int g2 = 0; g2 < 4; ++g2) {
            const int ai = g2 >> 1, mb = (g2 & 1) * 2;
            f32x4 pre[2][2][2];
#pragma unroll
            for (int mm = 0; mm < 2; ++mm)
#pragma unroll
                for (int bj = 0; bj < 2; ++bj)
#pragma unroll
                    for (int n = 0; n < 2; ++n) pre[mm][bj][n] = *(const PG8_GAS f32x4*)(hi + off0 + (unsigned)((ai * HALF + (mb + mm) * 16) * 1024 + bj * HALF + n * 16));
#pragma unroll
            for (int mm = 0; mm < 2; ++mm) { const int m = mb + mm; const unsigned off = off0 + (unsigned)((ai * HALF + m * 16) * 1024); float sq = 0.f;
#pragma unroll
                for (int bj = 0; bj < 2; ++bj)
#pragma unroll
                    for (int n = 0; n < 2; ++n) { const unsigned o_ = off + (unsigned)(bj * HALF + n * 16);
                        const f32x4 o = pre[mm][bj][n] + gv[bj][n] * acc[ai][bj][m][n]; *(PG8_GAS f32x4*)(ho + o_) = o;
                        if (nxt) { const f32x4 a = o * gsv[bj][n]; u32x2 w; w.x = cvt_pk_bf16(a[0], a[1]); w.y = cvt_pk_bf16(a[2], a[3]);
                            *(PG8_GAS u32x2*)(nht + o_) = w; sq += (o[0] * o[0] + o[1] * o[1]) + (o[2] * o[2] + o[3] * o[3]); } }
                if (nxt) { sq = xrow_sum(sq); if (fq == 0) sst[(size_t)(off >> 10) * 16 + u.pn * 4 + wc] = sq; } }
        }
    }
};

template <class Epi, class Sched, bool ALIGN_EPI, bool SP2, class Gm>
__device__ __forceinline__ void gemm_phase(PG8_LAS unsigned char* lds, const Gm g, const Sched& S, const Epi& E) {
    int tid = threadIdx.x; asm volatile("" : "+v"(tid));
    const int wid = __builtin_amdgcn_readfirstlane(tid >> 6), lane = tid & 63, wr = wid >> 2, wc = wid & 3, fr = lane & 15, fq = lane >> 4;
    constexpr int K = Gm::K, NTF = K / BK;
    unsigned voffA[2], voffB[2];
#pragma unroll
    for (int i = 0; i < 2; ++i) { int R, C; stage_rc(tid * 16 + i * 8192, R, C); const int Rb = Epi::PERM ? ((R & ~31) + perm32(R & 31)) : R;
        voffA[i] = (unsigned)(R * Gm::lda + C) * 2u; voffB[i] = (unsigned)(Rb * K + C) * 2u; }
    constexpr size_t kstep = (size_t)(BK * 2);
    constexpr size_t hstepA = (size_t)HALF * Gm::lda * 2, hstepB = (size_t)HALF * K * 2;
    constexpr size_t tstepA = 2 * hstepA, tstepB = 2 * hstepB;
    const unsigned ldsw = (unsigned)wid * 1024u;
    const int aoff = lds_byte(wr * 64 + fr, fq * 8), boff = lds_byte(wc * 32 + fr, fq * 8);
#define PG8_SA(b, h) (((b) * 2 + (h)) * HTB)
#define PG8_SB(b, h) ((4 + (b) * 2 + (h)) * HTB)
#define PG8_STAGE(bufoff, gbase, voff) do { _Pragma("unroll") for (int _i = 0; _i < 2; ++_i) \
        __builtin_amdgcn_global_load_lds((const unsigned*)((const char*)(gbase) + (voff)[_i]), (PG8_LAS unsigned*)(lds + (bufoff) + ldsw + _i * 8192), 16, 0, 0); } while (0)
#define PG8_LDA(dst, b, h) do { _Pragma("unroll") for (int m = 0; m < 4; ++m) _Pragma("unroll") for (int k = 0; k < 2; ++k) dst[m][k] = *(const PG8_LAS bf16x8*)(lds + PG8_SA(b, h) + aoff + m * 2048 + k * 1024); } while (0)
#define PG8_LDB(dst, b, h) do { _Pragma("unroll") for (int n = 0; n < 2; ++n) _Pragma("unroll") for (int k = 0; k < 2; ++k) dst[n][k] = *(const PG8_LAS bf16x8*)(lds + PG8_SB(b, h) + boff + n * 2048 + k * 1024); } while (0)
#define PG8_MMA(ai, bj, At, Bt) do { __builtin_amdgcn_s_setprio(1); _Pragma("unroll") for (int m = 0; m < 4; ++m) _Pragma("unroll") for (int n = 0; n < 2; ++n) _Pragma("unroll") for (int k = 0; k < 2; ++k) \
        acc[ai][bj][m][n] = __builtin_amdgcn_mfma_f32_16x16x32_bf16(Bt[n][k], At[m][k], acc[ai][bj][m][n], 0, 0, 0); __builtin_amdgcn_s_setprio(0); } while (0)
#define PG8_WAIT_V(n) asm volatile("s_waitcnt vmcnt(" #n ")" ::: "memory")
#define PG8_WAIT_L(n) asm volatile("s_waitcnt lgkmcnt(" #n ")" ::: "memory")
#define PG8_BAR __builtin_amdgcn_s_barrier()
#define PG8_SCHED __builtin_amdgcn_sched_barrier(0)
    Unit cur, nxt; int ui = 0;
    if (!S.next(0, cur)) return;
    int nt = cur.nt ? cur.nt : NTF;
    f32x4 acc[2][2][4][2];
#pragma unroll
    for (int a = 0; a < 2; ++a)
#pragma unroll
        for (int b = 0; b < 2; ++b)
#pragma unroll
            for (int m = 0; m < 4; ++m)
#pragma unroll
                for (int n = 0; n < 2; ++n) acc[a][b][m][n] = (f32x4){0.f, 0.f, 0.f, 0.f};
    bf16x8 At[4][2], B0[2][2], B1[2][2];
    const char* cA = (const char*)g.A + (size_t)cur.pm * tstepA + (size_t)cur.k0 * kstep; const char* cB = (const char*)g.Bt + (size_t)cur.pn * tstepB + (size_t)cur.k0 * kstep;
    S.a_ready(cur);
    if constexpr (SP2) {
        PG8_STAGE(PG8_SB(0, 0), cB, voffB); PG8_STAGE(PG8_SB(0, 1), cB + hstepB, voffB); PG8_STAGE(PG8_SA(0, 0), cA, voffA); PG8_STAGE(PG8_SA(0, 1), cA + hstepA, voffA);
        if (wr == 1) PG8_BAR;
        PG8_WAIT_V(2); PG8_BAR;
        PG8_STAGE(PG8_SB(1, 0), cB + kstep, voffB); PG8_STAGE(PG8_SA(1, 0), cA + kstep, voffA); PG8_STAGE(PG8_SB(1, 1), cB + hstepB + kstep, voffB);
        PG8_WAIT_V(6); PG8_BAR;
    } else {
        PG8_STAGE(PG8_SB(0, 0), cB, voffB); PG8_STAGE(PG8_SA(0, 0), cA, voffA); PG8_STAGE(PG8_SB(0, 1), cB + hstepB, voffB); PG8_STAGE(PG8_SA(0, 1), cA + hstepA, voffA);
        if (wr == 1) PG8_BAR;
        PG8_WAIT_V(4); PG8_BAR;
        PG8_STAGE(PG8_SB(1, 0), cB + kstep, voffB); PG8_STAGE(PG8_SA(1, 0), cA + kstep, voffA); PG8_STAGE(PG8_SB(1, 1), cB + hstepB + kstep, voffB);
        PG8_WAIT_V(6); PG8_BAR;
    }
    for (;;) {
        const bool has_next = S.next(ui + 1, nxt);
        const char* nA = has_next ? (const char*)g.A + (size_t)nxt.pm * tstepA + (size_t)nxt.k0 * kstep : cA; const char* nB = has_next ? (const char*)g.Bt + (size_t)nxt.pn * tstepB + (size_t)nxt.k0 * kstep : cB;
        for (int t = 0; t < nt; t += 2) {
            const bool last = (t == nt - 2);
            const char* a1 = cA + (size_t)(t + 1) * kstep;
            const char* a2 = last ? nA : cA + (size_t)(t + 2) * kstep; const char* b2 = last ? nB : cB + (size_t)(t + 2) * kstep;
            const char* a3 = a2 + kstep; const char* b3 = b2 + kstep;
            if (last && has_next) S.a_ready(nxt);
            if constexpr (SP2) {
            PG8_LDB(B0, 0, 0); PG8_LDB(B1, 0, 1); PG8_SCHED; PG8_LDA(At, 0, 0); PG8_STAGE(PG8_SA(1, 1), a1 + hstepA, voffA);
            PG8_WAIT_V(8); PG8_WAIT_L(0); PG8_BAR; PG8_MMA(0, 0, At, B0); PG8_MMA(0, 1, At, B1); PG8_BAR; PG8_SCHED;
            PG8_LDA(At, 0, 1); PG8_STAGE(PG8_SB(0, 0), b2, voffB); PG8_STAGE(PG8_SB(0, 1), b2 + hstepB, voffB); PG8_STAGE(PG8_SA(0, 0), a2, voffA);
            PG8_WAIT_V(8); PG8_WAIT_L(0); PG8_BAR; PG8_MMA(1, 0, At, B0); PG8_MMA(1, 1, At, B1); PG8_BAR; PG8_SCHED;
            PG8_LDB(B0, 1, 0); PG8_LDB(B1, 1, 1); PG8_SCHED; PG8_LDA(At, 1, 0); PG8_STAGE(PG8_SA(0, 1), a2 + hstepA, voffA);
            PG8_WAIT_V(8); PG8_WAIT_L(0); PG8_BAR; PG8_MMA(0, 0, At, B0); PG8_MMA(0, 1, At, B1); PG8_BAR; PG8_SCHED;
            PG8_LDA(At, 1, 1); PG8_STAGE(PG8_SB(1, 0), b3, voffB); PG8_STAGE(PG8_SB(1, 1), b3 + hstepB, voffB); PG8_STAGE(PG8_SA(1, 0), a3, voffA);
            PG8_WAIT_V(8); PG8_WAIT_L(0); PG8_BAR; PG8_MMA(1, 0, At, B0); PG8_MMA(1, 1, At, B1); PG8_BAR; PG8_SCHED;
            } else {
            PG8_LDB(B0, 0, 0); PG8_SCHED; PG8_LDA(At, 0, 0); PG8_STAGE(PG8_SA(1, 1), a1 + hstepA, voffA);
            PG8_WAIT_L(8); PG8_BAR; PG8_WAIT_L(0); PG8_MMA(0, 0, At, B0); PG8_BAR; PG8_SCHED;
            PG8_LDB(B1, 0, 1); PG8_STAGE(PG8_SB(0, 0), b2, voffB);
            PG8_BAR; PG8_WAIT_L(0); PG8_MMA(0, 1, At, B1); PG8_BAR;
            PG8_LDA(At, 0, 1); PG8_STAGE(PG8_SA(0, 0), a2, voffA);
            PG8_BAR; PG8_WAIT_L(0); PG8_MMA(1, 0, At, B0); PG8_BAR; PG8_SCHED;
            PG8_STAGE(PG8_SB(0, 1), b2 + hstepB, voffB);
            PG8_WAIT_V(6); PG8_BAR; PG8_MMA(1, 1, At, B1); PG8_BAR;
            PG8_LDB(B0, 1, 0); PG8_SCHED; PG8_LDA(At, 1, 0); PG8_STAGE(PG8_SA(0, 1), a2 + hstepA, voffA);
            PG8_WAIT_L(8); PG8_BAR; PG8_WAIT_L(0); PG8_MMA(0, 0, At, B0); PG8_BAR; PG8_SCHED;
            PG8_LDB(B1, 1, 1); PG8_STAGE(PG8_SB(1, 0), b3, voffB);
            PG8_BAR; PG8_WAIT_L(0); PG8_MMA(0, 1, At, B1); PG8_BAR;
            PG8_LDA(At, 1, 1); PG8_STAGE(PG8_SA(1, 0), a3, voffA);
            PG8_BAR; PG8_WAIT_L(0); PG8_MMA(1, 0, At, B0); PG8_BAR; PG8_SCHED;
            PG8_STAGE(PG8_SB(1, 1), b3 + hstepB, voffB);
            PG8_WAIT_V(6); PG8_BAR; PG8_MMA(1, 1, At, B1); PG8_BAR;
            }
        }
        if constexpr (ALIGN_EPI) { if (wr == 0) PG8_BAR; }
        if constexpr (!Epi::AFTER_DRAIN) { E(acc, cur, wr, wc, fr, fq); S.done(cur); }
        if (!has_next) break;
#pragma unroll
        for (int a = 0; a < 2; ++a)
#pragma unroll
            for (int b = 0; b < 2; ++b)
#pragma unroll
                for (int m = 0; m < 4; ++m)
#pragma unroll
                    for (int n = 0; n < 2; ++n) acc[a][b][m][n] = (f32x4){0.f, 0.f, 0.f, 0.f};
        cur = nxt; cA = nA; cB = nB; ++ui; nt = cur.nt ? cur.nt : NTF;
        if constexpr (ALIGN_EPI) { if (wr == 1) PG8_BAR; }
    }
    PG8_WAIT_V(0);
    if constexpr (!ALIGN_EPI) { if (wr == 0) PG8_BAR; }
    PG8_BAR;
    if constexpr (Epi::AFTER_DRAIN) { E.fused(acc, cur, wr, wc, fr, fq, lds, wid, lane); S.done(cur); }
#undef PG8_SA
#undef PG8_SB
#undef PG8_STAGE
#undef PG8_LDA
#undef PG8_LDB
#undef PG8_MMA
#undef PG8_WAIT_V
#undef PG8_WAIT_L
#undef PG8_BAR
#undef PG8_SCHED
}
}
namespace att {
using bf16x8 = __attribute__((ext_vector_type(8))) short;
using s16x4  = __attribute__((ext_vector_type(4))) short;
using f32x16 = __attribute__((ext_vector_type(16))) float;
using u32x4  = __attribute__((ext_vector_type(4))) unsigned;
typedef unsigned short bf16_t;
#define ATT_GAS __attribute__((address_space(1)))
constexpr int DQK = 192, DV = 128, NW = 8, QBLK = 32, KVBLK = 64;
constexpr int LDQ = 1536, LDKK = 1536, LDV = 1024, LDO = 1536;
constexpr int QREG = 6;
constexpr int SHM_V = KVBLK * DV * 2, SHM_K = KVBLK * DQK * 2, SHM_WS = NW * 64 * 4, SHM_QOFF = 2 * SHM_V + 2 * SHM_K + SHM_WS, SHM_ATTN = SHM_QOFF + NW * (12 - QREG) * 1024;
typedef float f32x4_ __attribute__((ext_vector_type(4)));
constexpr float QSCALE = 0.07216878364870322f * 1.4426950408889634f;
constexpr float THR = 8.0f;
#define KSWZ(row, colB) ((row) * 384 + ((colB) ^ (((row) & 7) << 4)))
#define SBAR() __builtin_amdgcn_sched_barrier(0)
__device__ __forceinline__ int crow(int r, int hi) { return (r & 3) + 8 * (r >> 2) + 4 * hi; }
__device__ __forceinline__ unsigned cvtpk(float lo, float hi) { unsigned r; asm volatile("v_cvt_pk_bf16_f32 %0, %1, %2" : "=v"(r) : "v"(lo), "v"(hi)); return r; }

__device__ __forceinline__ void partialSM(f32x16& p0, f32x16& p1, float& m_reg, float& mn, float& alpha) {
  float pmax = p0[0];
#pragma unroll
  for (int r = 1; r < 16; ++r) pmax = fmaxf(pmax, p0[r]);
#pragma unroll
  for (int r = 0; r < 16; ++r) pmax = fmaxf(pmax, p1[r]);
  { auto rr = __builtin_amdgcn_permlane32_swap(__float_as_uint(pmax), __float_as_uint(pmax), false, false);
    pmax = fmaxf(__uint_as_float(rr[0]), __uint_as_float(rr[1])); }
  if (__builtin_expect(__all(pmax - m_reg <= THR), 1)) { mn = m_reg; alpha = 1.f; }
  else { mn = fmaxf(m_reg, pmax); alpha = __builtin_amdgcn_exp2f(m_reg - mn); m_reg = mn; }
#pragma unroll
  for (int r = 0; r < 16; ++r) p0[r] = p0[r] - mn;
#pragma unroll
  for (int r = 0; r < 16; ++r) p1[r] = p1[r] - mn;
#pragma unroll
  for (int r = 0; r < 16; ++r) p0[r] = __builtin_amdgcn_exp2f(p0[r]);
}
__device__ __forceinline__ void finishSM(f32x16& p0, f32x16& p1, float alpha, float& l_reg, bf16x8& pa0, bf16x8& pa1, bf16x8& pa2, bf16x8& pa3) {
#pragma unroll
  for (int r = 0; r < 16; ++r) p1[r] = __builtin_amdgcn_exp2f(p1[r]);
  float ps = 0;
#pragma unroll
  for (int r = 0; r < 16; ++r) ps += p0[r];
#pragma unroll
  for (int r = 0; r < 16; ++r) ps += p1[r];
  { auto rr = __builtin_amdgcn_permlane32_swap(__float_as_uint(ps), __float_as_uint(ps), false, false);
    ps = __uint_as_float(rr[0]) + __uint_as_float(rr[1]); }
  l_reg = l_reg * alpha + ps;
#define PK4(P, BASE, OUT) do { unsigned a0 = cvtpk(P[BASE + 0], P[BASE + 1]), a1 = cvtpk(P[BASE + 2], P[BASE + 3]);   \
    unsigned b0 = cvtpk(P[BASE + 4], P[BASE + 5]), b1 = cvtpk(P[BASE + 6], P[BASE + 7]);                              \
    auto r0 = __builtin_amdgcn_permlane32_swap(a0, b0, false, false); auto r1 = __builtin_amdgcn_permlane32_swap(a1, b1, false, false); \
    u32x4 w = {r0[0], r1[0], r0[1], r1[1]}; OUT = __builtin_bit_cast(bf16x8, w); } while (0)
  PK4(p0, 0, pa0); PK4(p0, 8, pa1); PK4(p1, 0, pa2); PK4(p1, 8, pa3);
#undef PK4
}
__device__ __forceinline__ void qkt(f32x16& p0, f32x16& p1, const char* Ks, const bf16x8* qr, const char* ql, int r32, int hi) {
  p0 = f32x16{}; p1 = f32x16{};
#pragma unroll
  for (int d0 = 0; d0 < 12; ++d0) { const int cb = (d0 * 16 + hi * 8) * 2;
    bf16x8 b0 = *reinterpret_cast<const bf16x8*>(Ks + KSWZ(r32, cb));
    bf16x8 b1 = *reinterpret_cast<const bf16x8*>(Ks + KSWZ(32 + r32, cb));
    bf16x8 q;
    if (d0 < QREG) q = qr[d0]; else q = *reinterpret_cast<const bf16x8*>(ql + (d0 - QREG) * 1024);
    p0 = __builtin_amdgcn_mfma_f32_32x32x16_bf16(b0, q, p0, 0, 0, 0);
    p1 = __builtin_amdgcn_mfma_f32_32x32x16_bf16(b1, q, p1, 0, 0, 0); }
}
__device__ __forceinline__ int v_st(int k, int c) { const int kk = (k & ~0xC) | ((k & 4) << 1) | ((k & 8) >> 1); return ((kk >> 3) * 4 + (c >> 5)) * 512 + ((kk & 7) * 32 + (c & 31)) * 2; }
__device__ __forceinline__ int v_rd_base(int lane) { return ((lane & 3) << 3) | (((lane >> 2) & 3) << 6) | (((lane >> 4) & 1) << 5) | (((lane >> 5) & 1) << 8); }
constexpr int v_rd_off(int d0, int ks, int half) { return d0 * 512 + ks * 4096 + half * 2048; }
template <int OFF> __device__ __forceinline__ s16x4 tr_read(int vb) {
  s16x4 r; asm volatile("ds_read_b64_tr_b16 %0, %1 offset:%2" : "=&v"(r) : "v"(vb), "i"(OFF) : "memory"); return r;
}
template <int D0> __device__ __forceinline__ void pv_one(f32x16& od, int vb, bf16x8 pa0, bf16x8 pa1, bf16x8 pa2, bf16x8 pa3) {
  const s16x4 l0 = tr_read<v_rd_off(D0, 0, 0)>(vb), h0 = tr_read<v_rd_off(D0, 0, 1)>(vb), l1 = tr_read<v_rd_off(D0, 1, 0)>(vb), h1 = tr_read<v_rd_off(D0, 1, 1)>(vb);
  const s16x4 l2 = tr_read<v_rd_off(D0, 2, 0)>(vb), h2 = tr_read<v_rd_off(D0, 2, 1)>(vb), l3 = tr_read<v_rd_off(D0, 3, 0)>(vb), h3 = tr_read<v_rd_off(D0, 3, 1)>(vb);
  asm volatile("s_waitcnt lgkmcnt(0)" ::: "memory"); SBAR();
#define PK(L, H) (bf16x8){L[0], L[1], L[2], L[3], H[0], H[1], H[2], H[3]}
  od = __builtin_amdgcn_mfma_f32_32x32x16_bf16(pa0, PK(l0, h0), od, 0, 0, 0);
  od = __builtin_amdgcn_mfma_f32_32x32x16_bf16(pa1, PK(l1, h1), od, 0, 0, 0);
  od = __builtin_amdgcn_mfma_f32_32x32x16_bf16(pa2, PK(l2, h2), od, 0, 0, 0);
  od = __builtin_amdgcn_mfma_f32_32x32x16_bf16(pa3, PK(l3, h3), od, 0, 0, 0);
#undef PK
}
__device__ __forceinline__ void pv_d0(f32x16* o, int vb, bf16x8 pa0, bf16x8 pa1, bf16x8 pa2, bf16x8 pa3) {
  pv_one<0>(o[0], vb, pa0, pa1, pa2, pa3); pv_one<1>(o[1], vb, pa0, pa1, pa2, pa3); pv_one<2>(o[2], vb, pa0, pa1, pa2, pa3); pv_one<3>(o[3], vb, pa0, pa1, pa2, pa3);
}

__device__ __forceinline__ void attn_unit(const bf16_t* __restrict__ Qg, const bf16_t* __restrict__ Kg, const bf16_t* __restrict__ Vg, bf16_t* __restrict__ Og,
                                          int qrow0, int h, int NT, int nctx_t, int kc0, int kl0, char* lds, const float* gq, const float* ropetab, bool lat) {
  int tid = threadIdx.x; asm volatile("" : "+v"(tid));
  const int wid = tid >> 6, lane = tid & 63, r32 = lane & 31, hi = lane >> 5;
  char* V_lds = lds; char* K_lds = lds + 2 * SHM_V;
  float* ws = (float*)(lds + 2 * SHM_V + 2 * SHM_K) + wid * 64; float* li_l = ws; float* al_l = ws + 32;
  float m_reg = -1e30f, l_reg = 0; f32x16 o[4] = {}; bf16x8 qr[QREG];
  char* ql = lds + SHM_QOFF + wid * ((12 - QREG) * 1024) + lane * 16;
  const ATT_GAS bf16_t* Qw = (const ATT_GAS bf16_t*)(Qg + (size_t)(qrow0 + wid * QBLK + r32) * LDQ + h * DQK + hi * 8);
  { u32x4 qraw[12];
#pragma unroll
    for (int d0 = 0; d0 < 12; ++d0) qraw[d0] = *(const ATT_GAS u32x4*)(Qw + d0 * 16);
    float ss = 0.f;
#pragma unroll
    for (int d0 = 0; d0 < 12; ++d0) { const u32x4 w = qraw[d0];
#pragma unroll
      for (int i = 0; i < 4; ++i) { const float lo = __builtin_bit_cast(float, w[i] << 16), hi_ = __builtin_bit_cast(float, w[i] & 0xffff0000u); ss += lo * lo + hi_ * hi_; } }
    { auto rr = __builtin_amdgcn_permlane32_swap(__float_as_uint(ss), __float_as_uint(ss), false, false); ss = __uint_as_float(rr[0]) + __uint_as_float(rr[1]); }
    const float rq = rsqrtf(ss * (1.0f / 192.0f) + 1e-6f) * QSCALE;
    const ATT_GAS float* gp = (const ATT_GAS float*)gq + hi * 8;
    const int tpos = (qrow0 + wid * QBLK + r32) & 2047;
#define QUNPK(W, X) do { _Pragma("unroll") for (int i_ = 0; i_ < 4; ++i_) { X[2 * i_] = __builtin_bit_cast(float, W[i_] << 16); X[2 * i_ + 1] = __builtin_bit_cast(float, W[i_] & 0xffff0000u); } } while (0)
#define QPUT(D0, Y) do { u32x4 w_ = {cvtpk(Y[0], Y[1]), cvtpk(Y[2], Y[3]), cvtpk(Y[4], Y[5]), cvtpk(Y[6], Y[7])}; const bf16x8 f_ = __builtin_bit_cast(bf16x8, w_); \
      if ((D0) < QREG) qr[(D0) < QREG ? (D0) : 0] = f_; else *reinterpret_cast<bf16x8*>(ql + ((D0) - QREG) * 1024) = f_; } while (0)
#pragma unroll
    for (int d0 = 0; d0 < 8; ++d0) { float x[8]; QUNPK(qraw[d0], x); const f32x4_ g0 = *(const ATT_GAS f32x4_*)(gp + d0 * 16), g1 = *(const ATT_GAS f32x4_*)(gp + d0 * 16 + 4);
#pragma unroll
      for (int i = 0; i < 4; ++i) { x[i] = x[i] * rq * g0[i]; x[4 + i] = x[4 + i] * rq * g1[i]; }
      QPUT(d0, x); }
#pragma unroll
    for (int ax = 0; ax < 2; ++ax) { float x1[8], x2[8]; QUNPK(qraw[8 + 2 * ax], x1); QUNPK(qraw[9 + 2 * ax], x2);
      const f32x4_ ga0 = *(const ATT_GAS f32x4_*)(gp + (8 + 2 * ax) * 16), ga1 = *(const ATT_GAS f32x4_*)(gp + (8 + 2 * ax) * 16 + 4), gb0 = *(const ATT_GAS f32x4_*)(gp + (9 + 2 * ax) * 16), gb1 = *(const ATT_GAS f32x4_*)(gp + (9 + 2 * ax) * 16 + 4);
      const ATT_GAS float* ct = (const ATT_GAS float*)ropetab + ((size_t)tpos * 2 + ax) * 16 + hi * 8;
      const f32x4_ c0 = *(const ATT_GAS f32x4_*)ct, c1 = *(const ATT_GAS f32x4_*)(ct + 4), s0 = *(const ATT_GAS f32x4_*)(ct + 2048 * 32), s1 = *(const ATT_GAS f32x4_*)(ct + 2048 * 32 + 4);
#pragma unroll
      for (int i = 0; i < 8; ++i) { const float g1_ = i < 4 ? ga0[i & 3] : ga1[i & 3], g2_ = i < 4 ? gb0[i & 3] : gb1[i & 3], c = i < 4 ? c0[i & 3] : c1[i & 3], s = i < 4 ? s0[i & 3] : s1[i & 3];
        const float y1 = x1[i] * rq * g1_, y2 = x2[i] * rq * g2_; x1[i] = lat ? (y1 * c - y2 * s) : y1; x2[i] = lat ? (y1 * s + y2 * c) : y2; }
      QPUT(8 + 2 * ax, x1); QPUT(9 + 2 * ax, x2); }
#undef QUNPK
#undef QPUT
  }
  const int sr = tid >> 4, sc = (tid & 15) * 8, vst0 = v_st(sr, sc), vst1 = v_st(32 + sr, sc);
  const int kr0 = tid / 24, kc0_ = (tid % 24) * 8, kr1 = (tid + 512) / 24, kc1_ = ((tid + 512) % 24) * 8, kr2 = (tid + 1024) / 24, kc2_ = ((tid + 1024) % 24) * 8;
  const int kst0 = KSWZ(kr0, kc0_ * 2), kst1 = KSWZ(kr1, kc1_ * 2), kst2 = KSWZ(kr2, kc2_ * 2);
  const int vb0 = (int)(uintptr_t)V_lds + v_rd_base(lane);
  const ATT_GAS bf16_t* Kh = (const ATT_GAS bf16_t*)(Kg + h * DQK); const ATT_GAS bf16_t* Vh = (const ATT_GAS bf16_t*)(Vg + h * DV);
  bf16x8 vs0, vs1, ks0, ks1, ks2;
#define KROW(t) ((t) < nctx_t ? kc0 + 64 * (t) : kl0 + 64 * ((t) - nctx_t))
#define SLOAD(t) do { const size_t k0_ = (size_t)KROW(t); \
    vs0 = *(const ATT_GAS bf16x8*)(&Vh[(k0_ + sr) * LDV + sc]); vs1 = *(const ATT_GAS bf16x8*)(&Vh[(k0_ + 32 + sr) * LDV + sc]); \
    ks0 = *(const ATT_GAS bf16x8*)(&Kh[(k0_ + kr0) * LDKK + kc0_]); ks1 = *(const ATT_GAS bf16x8*)(&Kh[(k0_ + kr1) * LDKK + kc1_]); \
    ks2 = *(const ATT_GAS bf16x8*)(&Kh[(k0_ + kr2) * LDKK + kc2_]); } while (0)
#define SWRITE(b) do { *(bf16x8*)(V_lds + (b) * SHM_V + vst0) = vs0; *(bf16x8*)(V_lds + (b) * SHM_V + vst1) = vs1; \
    *(bf16x8*)(K_lds + (b) * SHM_K + kst0) = ks0; *(bf16x8*)(K_lds + (b) * SHM_K + kst1) = ks1; *(bf16x8*)(K_lds + (b) * SHM_K + kst2) = ks2; } while (0)
#define SWAIT() asm volatile("s_waitcnt vmcnt(0)" ::: "memory")
#define RESC(a) do { if (__any((a) < 1.f)) { if (hi == 0) al_l[r32] = (a); asm volatile("s_waitcnt lgkmcnt(0)" ::: "memory"); \
    _Pragma("unroll") for (int d = 0; d < 4; ++d) _Pragma("unroll") for (int r = 0; r < 16; ++r) o[d][r] *= al_l[crow(r, hi)]; } } while (0)
  f32x16 pA0, pA1, pB0, pB1; float mnA, mnB, alA, alB; bf16x8 pa0, pa1, pa2, pa3;
  SLOAD(0); SWAIT(); SWRITE(0); __syncthreads();
  qkt(pA0, pA1, K_lds, qr, ql, r32, hi); partialSM(pA0, pA1, m_reg, mnA, alA);
  SLOAD(1);
  SWAIT(); SWRITE(1); __syncthreads();
  for (int j = 1; j + 1 < NT; j += 2) {
    SBAR(); qkt(pB0, pB1, K_lds + SHM_K, qr, ql, r32, hi);
    finishSM(pA0, pA1, alA, l_reg, pa0, pa1, pa2, pa3); SBAR();
    SLOAD(j + 1); SBAR();
    pv_d0(o, vb0, pa0, pa1, pa2, pa3); partialSM(pB0, pB1, m_reg, mnB, alB);
    __syncthreads(); SWAIT(); SWRITE(0);
    RESC(alB); __syncthreads();
    SBAR(); qkt(pA0, pA1, K_lds, qr, ql, r32, hi);
    finishSM(pB0, pB1, alB, l_reg, pa0, pa1, pa2, pa3); SBAR();
    SLOAD(j + 2); SBAR();
    pv_d0(o, vb0 + SHM_V, pa0, pa1, pa2, pa3); partialSM(pA0, pA1, m_reg, mnA, alA);
    __syncthreads(); SWAIT(); SWRITE(1);
    RESC(alA); __syncthreads();
  }
  SBAR(); qkt(pB0, pB1, K_lds + SHM_K, qr, ql, r32, hi);
  finishSM(pA0, pA1, alA, l_reg, pa0, pa1, pa2, pa3); SBAR();
  pv_d0(o, vb0, pa0, pa1, pa2, pa3); partialSM(pB0, pB1, m_reg, mnB, alB);
  __syncthreads(); RESC(alB);
  finishSM(pB0, pB1, alB, l_reg, pa0, pa1, pa2, pa3); SBAR();
  pv_d0(o, vb0 + SHM_V, pa0, pa1, pa2, pa3);
  if (hi == 0) li_l[r32] = l_reg; asm volatile("s_waitcnt lgkmcnt(0)" ::: "memory");
  float rli[16];
#pragma unroll
  for (int r = 0; r < 16; ++r) rli[r] = __builtin_amdgcn_rcpf(li_l[crow(r, hi)]);
  ATT_GAS bf16_t* Ow = (ATT_GAS bf16_t*)(Og + (size_t)(qrow0 + wid * QBLK) * LDO + h * DQK);
#pragma unroll
  for (int r = 0; r < 16; ++r) { const int orow = crow(r, hi);
#pragma unroll
    for (int d0 = 0; d0 < 4; ++d0) { const unsigned w = cvtpk(o[d0][r] * rli[r], 0.f); Ow[(size_t)orow * LDO + d0 * 32 + r32] = (bf16_t)(w & 0xffffu); } }
  __syncthreads();
#undef KROW
#undef SLOAD
#undef SWRITE
#undef SWAIT
#undef RESC
}
#undef KSWZ
#undef SBAR
}

#define LAS __attribute__((address_space(3)))
#define GAS __attribute__((address_space(1)))
typedef unsigned short bf16;
typedef float f32x4 __attribute__((ext_vector_type(4)));
typedef unsigned u32x4 __attribute__((ext_vector_type(4)));
typedef unsigned u32x2 __attribute__((ext_vector_type(2)));

constexpr int D = 1024, NBATCH = 16, SEQ = 2048, CTXL = 256, DEPTH = 4;
constexpr int RL = NBATCH * SEQ, RC = NBATCH * CTXL, RT = RL + RC;
constexpr int DFF = 2816, NCOND = 17, MODW = 9 * D;
constexpr float EPS = 1e-6f;
constexpr float QSC = 0.07216878364870322f * 1.4426950408889634f;
constexpr int NWAVES = 8;
constexpr int LDS_BYTES = 147456;

enum { I_X = 0, I_C, I_CTX, I_CCTX, I_WMOD, I_BMOD, I_GNORM, I_W1, I_W3, I_W2, I_SCWIN, I_SCCONV, I_SCWOUT, I_WA, I_GQA, I_WUQ, I_GKVA, I_WUKV, I_GQ, I_GK, I_WO, N_IN };

constexpr size_t MiB = 1u << 20;
constexpr size_t OFF_MOD = 0;
constexpr size_t OFF_ROPE = 4 * MiB;
constexpr size_t OFF_STAT = 4 * MiB + 512 * 1024;
constexpr size_t OFF_CTL = 6 * MiB, CTL_BYTES = 65536;

constexpr size_t OFF_WUP = 8 * MiB;
constexpr size_t SZ_WUP = (size_t)5632 * 1024 * 2;
constexpr size_t OFF_WDN = 96 * MiB;
constexpr size_t SZ_WDN = (size_t)1024 * 2816 * 2;
constexpr size_t OFF_WIN = 140 * MiB;
constexpr size_t SZ_WIN = (size_t)3072 * 1024 * 2;
constexpr size_t OFF_WOUT = 152 * MiB;
constexpr size_t SZ_SQ = (size_t)1024 * 1024 * 2;
constexpr size_t OFF_WA = 156 * MiB;
constexpr size_t SZ_WA = (size_t)512 * 1024 * 2;
constexpr size_t OFF_WUQ = 158 * MiB;
constexpr size_t SZ_WUQ = (size_t)1536 * 256 * 2;
constexpr size_t OFF_WUKV = 160 * MiB;
constexpr size_t SZ_WUKV = (size_t)2048 * 128 * 2;
constexpr size_t OFF_WO = 160 * MiB + 2 * MiB;
constexpr size_t SZ_WO = (size_t)1024 * 1536 * 2;
constexpr size_t OFF_HCTX = 168 * MiB;
constexpr size_t OFF_NH = 184 * MiB;
constexpr size_t OFF_BIG = 256 * MiB;
constexpr size_t OFF_ACT = OFF_BIG;
constexpr size_t OFF_BB = OFF_BIG;
constexpr size_t OFF_VV = OFF_BIG + 72 * MiB;
constexpr size_t OFF_YY = OFF_BIG + 144 * MiB;
constexpr size_t OFF_CQKV = OFF_BIG;
constexpr size_t OFF_Q = OFF_BIG + 36 * MiB;
constexpr size_t OFF_K = OFF_BIG + 144 * MiB;
constexpr size_t OFF_V = OFF_BIG + 252 * MiB;
constexpr size_t OFF_BIAS = OFF_BIG + 324 * MiB;
constexpr size_t BIAS_UP = 0, BIAS_WIN = (size_t)8 * 17 * 5632, BIAS_WA = BIAS_WIN + (size_t)2 * 17 * 3072;
constexpr size_t OFF_SS = OFF_BIAS + 4 * MiB;
constexpr size_t WS_END = OFF_BIAS + 8 * MiB;

struct Params { const float* in[N_IN]; float* out; unsigned char* ws; int pad0, pad1; };
constexpr int MISC_OFF = LDS_BYTES - 512;
constexpr int PTAB_OFF = LDS_BYTES - 256, I_OUT = N_IN, I_WS = N_IN + 1;
__device__ __forceinline__ unsigned long long ldp_raw(int i) {
    volatile LAS unsigned* t = (volatile LAS unsigned*)(uintptr_t)PTAB_OFF;
    const unsigned lo = __builtin_amdgcn_readfirstlane(t[2 * i]), hi = __builtin_amdgcn_readfirstlane(t[2 * i + 1]);
    return ((unsigned long long)hi << 32) | lo;
}
__device__ __forceinline__ const float* ldp(int i) { return (const float*)ldp_raw(i); }
__device__ __forceinline__ unsigned char* ldws() { return (unsigned char*)ldp_raw(I_WS); }

__device__ __forceinline__ float wave_sum(float v) {
#pragma unroll
    for (int o = 1; o < 64; o <<= 1) v += __shfl_xor(v, o);
    return v;
}
__device__ __forceinline__ float wave_sum_dpp(float v) {
    v += __builtin_bit_cast(float, __builtin_amdgcn_mov_dpp(__builtin_bit_cast(int, v), 0xB1, 0xf, 0xf, false));
    v += __builtin_bit_cast(float, __builtin_amdgcn_mov_dpp(__builtin_bit_cast(int, v), 0x4E, 0xf, 0xf, false));
    v += __builtin_bit_cast(float, __builtin_amdgcn_mov_dpp(__builtin_bit_cast(int, v), 0x141, 0xf, 0xf, false));
    v += __builtin_bit_cast(float, __builtin_amdgcn_mov_dpp(__builtin_bit_cast(int, v), 0x140, 0xf, 0xf, false));
    return pg8::xrow_sum(v);
}
__device__ __forceinline__ unsigned f2bf(float f) { unsigned u = __builtin_bit_cast(unsigned, f); return (u + 0x7fffu + ((u >> 16) & 1u)) >> 16; }
__device__ __forceinline__ unsigned pk2(float lo, float hi) { return f2bf(lo) | (f2bf(hi) << 16); }
__device__ __forceinline__ float bf_lo(unsigned w) { return __builtin_bit_cast(float, w << 16); }
__device__ __forceinline__ float bf_hi(unsigned w) { return __builtin_bit_cast(float, w & 0xffff0000u); }

__device__ __forceinline__ void transpose_item(const float* W, int K, int N, bf16* WT, int Kd, int mode, const float* kscale, LAS float* scr, int item, int lane) {
    const int nblk = N / 32, kb = item / nblk, nb = item % nblk, k0 = 64 * kb, n0 = 32 * nb;
    float tv[32];
#pragma unroll
    for (int i = 0; i < 32; ++i) { const int kk = 2 * i + (lane >> 5); tv[i] = W[(size_t)(k0 + kk) * N + n0 + (lane & 31)]; }
#pragma unroll
    for (int i = 0; i < 32; ++i) { const int kk = 2 * i + (lane >> 5); scr[kk * 33 + (lane & 31)] = tv[i]; }
    asm volatile("s_waitcnt lgkmcnt(0)" ::: "memory");
    int r0;
    if (mode == 0) r0 = n0;
    else if (mode == 1) r0 = 256 * (n0 >> 7) + (n0 & 127);
    else if (mode == 2) r0 = 256 * (n0 >> 7) + 128 + (n0 & 127);
    else { if (n0 < 1024) r0 = n0; else if (n0 < 2048) { const int c = n0 - 1024; r0 = 1024 + 256 * (c >> 7) + (c & 127); } else { const int c = n0 - 2048; r0 = 1024 + 256 * (c >> 7) + 128 + (c & 127); } }
    const int c = lane & 7; const int kd0 = (mode == 4) ? 192 * (k0 >> 7) + (k0 & 127) : k0;
    float ks[8];
#pragma unroll
    for (int q = 0; q < 8; ++q) ks[q] = kscale ? kscale[k0 + 8 * c + q] : 1.0f;
#pragma unroll
    for (int j = 0; j < 4; ++j) { const int n = (lane >> 3) + 8 * j; const LAS float* s = scr + (8 * c) * 33 + n;
        u32x4 o; o.x = pk2(s[0 * 33] * ks[0], s[1 * 33] * ks[1]); o.y = pk2(s[2 * 33] * ks[2], s[3 * 33] * ks[3]); o.z = pk2(s[4 * 33] * ks[4], s[5 * 33] * ks[5]); o.w = pk2(s[6 * 33] * ks[6], s[7 * 33] * ks[7]);
        *(u32x4*)(WT + (size_t)(r0 + n) * Kd + kd0 + 8 * c) = o; }
    asm volatile("s_waitcnt lgkmcnt(0)" ::: "memory");
}

constexpr int IT_FFN = 1408;
constexpr int IT_A0 = 0, IT_B0 = IT_A0 + 8 * IT_FFN, IT_C0 = IT_B0 + 8 * IT_FFN, IT_D0 = IT_C0 + 8 * IT_FFN;
constexpr int IT_WIN = 16 * 96, IT_SQ = 16 * 32, IT_WA = 16 * 14, IT_WUQ = 4 * 48, IT_WUKV = 2 * 64;
constexpr int IT_E0 = IT_D0 + 2 * IT_WIN, IT_F0 = IT_E0 + 2 * IT_SQ, IT_G0 = IT_F0 + 2 * IT_SQ, IT_H0 = IT_G0 + 2 * IT_WA, IT_I0 = IT_H0 + 2 * IT_WUQ, IT_END = IT_I0 + 2 * IT_WUKV;

__device__ __forceinline__ void convert_item(int it, LAS float* scr, int lane) {
    unsigned char* ws = ldws();
    if (it < IT_B0) { const int m = it / IT_FFN, r = it % IT_FFN; transpose_item(ldp(I_W1) + (size_t)m * D * DFF, D, DFF, (bf16*)(ws + OFF_WUP + m * SZ_WUP), D, 1, nullptr, scr, r, lane); return; }
    if (it < IT_C0) { it -= IT_B0; const int m = it / IT_FFN, r = it % IT_FFN; transpose_item(ldp(I_W3) + (size_t)m * D * DFF, D, DFF, (bf16*)(ws + OFF_WUP + m * SZ_WUP), D, 2, nullptr, scr, r, lane); return; }
    if (it < IT_D0) { it -= IT_C0; const int m = it / IT_FFN, r = it % IT_FFN; transpose_item(ldp(I_W2) + (size_t)m * DFF * D, DFF, D, (bf16*)(ws + OFF_WDN + m * SZ_WDN), DFF, 0, nullptr, scr, r, lane); return; }
    if (it < IT_E0) { it -= IT_D0; const int m = it / IT_WIN, r = it % IT_WIN; transpose_item(ldp(I_SCWIN) + (size_t)m * D * 3072, D, 3072, (bf16*)(ws + OFF_WIN + m * SZ_WIN), D, 3, nullptr, scr, r, lane); return; }
    if (it < IT_F0) { it -= IT_E0; const int m = it / IT_SQ, r = it % IT_SQ; transpose_item(ldp(I_SCWOUT) + (size_t)m * D * D, D, D, (bf16*)(ws + OFF_WOUT + m * SZ_SQ), D, 0, nullptr, scr, r, lane); return; }
    if (it < IT_G0) { it -= IT_F0; const int m = it / IT_SQ, r = it % IT_SQ; transpose_item(ldp(I_WO) + (size_t)m * D * D, D, D, (bf16*)(ws + OFF_WO + m * SZ_WO), 1536, 4, nullptr, scr, r, lane); return; }
    if (it < IT_H0) { it -= IT_G0; const int m = it / IT_WA, r = it % IT_WA; transpose_item(ldp(I_WA) + (size_t)m * D * 448, D, 448, (bf16*)(ws + OFF_WA + m * SZ_WA), D, 0, nullptr, scr, r, lane); return; }
    if (it < IT_I0) { it -= IT_H0; const int m = it / IT_WUQ, r = it % IT_WUQ; transpose_item(ldp(I_WUQ) + (size_t)m * 256 * 1536, 256, 1536, (bf16*)(ws + OFF_WUQ + m * SZ_WUQ), 256, 0, ldp(I_GQA) + m * 256, scr, r, lane); return; }
    { it -= IT_I0; const int m = it / IT_WUKV, r = it % IT_WUKV; transpose_item(ldp(I_WUKV) + (size_t)m * 128 * 2048, 128, 2048, (bf16*)(ws + OFF_WUKV + m * SZ_WUKV), 128, 0, ldp(I_GKVA) + m * 128, scr, r, lane); }
}

__device__ __forceinline__ void mod_group(int grp, LAS unsigned char* lds, int tid, int wave, int lane) {
    LAS float* S = (LAS float*)lds;
    const float* cin = ldp(I_C); const float* cctx = ldp(I_CCTX);
    for (int i = tid; i < NCOND * 1024; i += 512) { const int c = i >> 10, k = i & 1023; const float v = c < 16 ? cin[c * 1024 + k] : cctx[k]; S[i] = v / (1.0f + __expf(-v)); }
    __syncthreads();
    const int l = grp / 36, cg0 = (grp % 36) * 256;
    const float* W = ldp(I_WMOD) + (size_t)l * 1024 * MODW + cg0 + lane * 4;
    const int kbase = wave * 128;
    f32x4 acc[NCOND];
#pragma unroll
    for (int c = 0; c < NCOND; ++c) acc[c] = (f32x4){0.f, 0.f, 0.f, 0.f};
    for (int kk = 0; kk < 128; kk += 4) {
        const float* wp = W + (size_t)(kbase + kk) * MODW;
        const f32x4 w0 = *(const f32x4*)(wp), w1 = *(const f32x4*)(wp + MODW), w2 = *(const f32x4*)(wp + 2 * MODW), w3 = *(const f32x4*)(wp + 3 * MODW);
#pragma unroll
        for (int c = 0; c < NCOND; ++c) { const f32x4 s = *(const LAS f32x4*)(S + c * 1024 + kbase + kk); acc[c] += w0 * s.x + w1 * s.y + w2 * s.z + w3 * s.w; }
    }
    __syncthreads();
    LAS float* P = (LAS float*)lds;
#pragma unroll
    for (int c = 0; c < NCOND; ++c) *(LAS f32x4*)(P + (wave * NCOND + c) * 256 + lane * 4) = acc[c];
    __syncthreads();
    float* MOD = (float*)(ldws() + OFF_MOD); const float* bmod = ldp(I_BMOD);
    for (int o = tid; o < NCOND * 256; o += 512) { const int c = o >> 8, col = o & 255; float s = bmod[l * MODW + cg0 + col];
#pragma unroll
        for (int w = 0; w < 8; ++w) s += P[(w * NCOND + c) * 256 + col];
        MOD[(size_t)(l * NCOND + c) * MODW + cg0 + col] = s; }
    __syncthreads();
}

__device__ __forceinline__ void norm_phase(const float* hl, const float* hc, const float* g, const float* modl, int chunk, bf16* NH, int nrows, int gw, int NGW, int lane) {
    for (int row = gw; row < nrows; row += NGW) {
        const float* src = row < RL ? hl + (size_t)row * D : hc + (size_t)(row - RL) * D;
        const int cond = row < RL ? (row >> 11) : 16;
        const float* sh = modl + (size_t)cond * MODW + chunk * D; const float* sc = sh + D;
        f32x4 v[4]; float s = 0.f;
#pragma unroll
        for (int j = 0; j < 4; ++j) { v[j] = ((const f32x4*)src)[lane + 64 * j]; s += (v[j].x * v[j].x + v[j].y * v[j].y) + (v[j].z * v[j].z + v[j].w * v[j].w); }
        const float rstd = rsqrtf(wave_sum(s) * (1.0f / D) + EPS);
        u32x2* o8 = (u32x2*)(NH + (size_t)row * D) + lane;
#pragma unroll
        for (int j = 0; j < 4; ++j) { const f32x4 gg = ((const f32x4*)g)[lane + 64 * j], ss = ((const f32x4*)sc)[lane + 64 * j], hh = ((const f32x4*)sh)[lane + 64 * j];
            const f32x4 y = v[j] * rstd * gg * (ss + 1.0f) + hh; u32x2 w; w.x = pk2(y.x, y.y); w.y = pk2(y.z, y.w); o8[64 * j] = w; }
    }
}


__device__ __forceinline__ void bias_unit(int unit, LAS unsigned char* lds, int tid, int wave, int lane) {
    unsigned char* ws = ldws(); const float* MOD = (const float*)(ws + OFF_MOD); float* BIAS = (float*)(ws + OFF_BIAS);
    int l, chunk, N, row0; const bf16* Bt; float* out;
    if (unit < 352) { const int m = unit / 44; l = m >> 1; chunk = (m & 1) ? 6 : 0; N = 5632; row0 = (unit % 44) * 128; Bt = (const bf16*)(ws + OFF_WUP + m * SZ_WUP); out = BIAS + BIAS_UP + (size_t)m * 17 * 5632; }
    else if (unit < 400) { const int j = (unit - 352) / 24; l = 2 * j; chunk = 3; N = 3072; row0 = ((unit - 352) % 24) * 128; Bt = (const bf16*)(ws + OFF_WIN + j * SZ_WIN); out = BIAS + BIAS_WIN + (size_t)j * 17 * 3072; }
    else { const int j = (unit - 400) / 4; l = 2 * j + 1; chunk = 3; N = 512; row0 = ((unit - 400) % 4) * 128; Bt = (const bf16*)(ws + OFF_WA + j * SZ_WA); out = BIAS + BIAS_WA + (size_t)j * 17 * 512; }
    LAS float* S = (LAS float*)lds;
    __syncthreads();
    for (int i = tid; i < NCOND * 1024; i += 512) { const int c = i >> 10, k = i & 1023; S[i] = MOD[(size_t)(l * NCOND + c) * MODW + chunk * D + k]; }
    __syncthreads();
    for (int r = 0; r < 16; ++r) { const int n = row0 + wave * 16 + r;
        float w[16];
#pragma unroll
        for (int q = 0; q < 4; ++q) { const u32x2 v = *(const u32x2*)(Bt + (size_t)n * D + 256 * q + 4 * lane); w[4 * q] = bf_lo(v.x); w[4 * q + 1] = bf_hi(v.x); w[4 * q + 2] = bf_lo(v.y); w[4 * q + 3] = bf_hi(v.y); }
        float mine = 0.f;
#pragma unroll
        for (int c = 0; c < NCOND; ++c) { float a = 0.f;
#pragma unroll
            for (int q = 0; q < 4; ++q) { const f32x4 sv = *(const LAS f32x4*)(S + c * 1024 + 256 * q + 4 * lane); a += sv.x * w[4 * q] + sv.y * w[4 * q + 1] + sv.z * w[4 * q + 2] + sv.w * w[4 * q + 3]; }
            a = wave_sum_dpp(a); mine = (lane == c) ? a : mine; }
        if (lane < NCOND) out[(size_t)lane * N + n] = mine;
    }
}
__device__ __forceinline__ void first_aprime(const float* xl, const float* xc, const float* g, const float* sc0, bf16* NH, float* SS, int gw, int NGW, int lane) {
    for (int row0 = gw; row0 < RT; row0 += 2 * NGW) {
        f32x4 v[2][4];
#pragma unroll
        for (int q = 0; q < 2; ++q) { const int row = (row0 + q * NGW < RT) ? row0 + q * NGW : row0; const float* src = row < RL ? xl + (size_t)row * D : xc + (size_t)(row - RL) * D;
#pragma unroll
            for (int j = 0; j < 4; ++j) v[q][j] = ((const f32x4*)src)[lane + 64 * j]; }
#pragma unroll
        for (int q = 0; q < 2; ++q) { const int row = row0 + q * NGW; if (row < RT) {
            const int cond = row < RL ? (row >> 11) : 16; const float* sc = sc0 + (size_t)cond * MODW; float s = 0.f;
#pragma unroll
            for (int j = 0; j < 4; ++j) s += (v[q][j].x * v[q][j].x + v[q][j].y * v[q][j].y) + (v[q][j].z * v[q][j].z + v[q][j].w * v[q][j].w);
            s = wave_sum_dpp(s); if (lane < 16) SS[(size_t)row * 16 + lane] = (lane == 0) ? s : 0.f;
            u32x2* o8 = (u32x2*)(NH + (size_t)row * D) + lane;
#pragma unroll
            for (int j = 0; j < 4; ++j) { const f32x4 gg = ((const f32x4*)g)[lane + 64 * j], ss = ((const f32x4*)sc)[lane + 64 * j];
                const f32x4 y = v[q][j] * gg * (ss + 1.0f); u32x2 w; w.x = pk2(y.x, y.y); w.y = pk2(y.z, y.w); o8[64 * j] = w; } } }
    }
}


__device__ __forceinline__ void ctx_fix(const float* hin, float* hout, const float* part, const float* gate16, float gs, bf16* NHc, float* SSc_, const float* gn, const float* sc16, int gw, int NGW, int lane) {
    for (int r = gw; r < RC; r += NGW) {
        const GAS f32x4* hp = (const GAS f32x4*)(hin + (size_t)r * D) + lane; GAS f32x4* op = (GAS f32x4*)(hout + (size_t)r * D) + lane;
        f32x4 h[4], p[4][4];
#pragma unroll
        for (int j = 0; j < 4; ++j) { h[j] = hp[64 * j];
#pragma unroll
            for (int q = 0; q < 4; ++q) { const u32x2 w_ = ((const GAS u32x2*)((const bf16*)part + ((size_t)q * RC + r) * D) + lane)[64 * j]; p[q][j] = (f32x4){bf_lo(w_.x), bf_hi(w_.x), bf_lo(w_.y), bf_hi(w_.y)}; } }
        float sq = 0.f; f32x4 o[4];
#pragma unroll
        for (int j = 0; j < 4; ++j) { const f32x4 gg = ((const f32x4*)gate16)[lane + 64 * j] * gs; o[j] = h[j] + gg * (((p[0][j] + p[1][j]) + p[2][j]) + p[3][j]); op[64 * j] = o[j];
            sq += (o[j].x * o[j].x + o[j].y * o[j].y) + (o[j].z * o[j].z + o[j].w * o[j].w); }
        if (gn) {
            sq = wave_sum_dpp(sq); if (lane < 16) SSc_[(size_t)(RL + r) * 16 + lane] = (lane == 0) ? sq : 0.f;
            GAS u32x2* a8 = (GAS u32x2*)(NHc + (size_t)(RL + r) * D) + lane;
#pragma unroll
            for (int j = 0; j < 4; ++j) { const f32x4 y = o[j] * ((const f32x4*)gn)[lane + 64 * j] * (((const f32x4*)sc16)[lane + 64 * j] + 1.0f); u32x2 w; w.x = pk2(y.x, y.y); w.y = pk2(y.z, y.w); a8[64 * j] = w; }
        }
    }
}

__device__ __forceinline__ void stats_phase(const bf16* CQKV, float* rq, float* rkv, int gw, int NGW, int lane) {
    for (int row = gw; row < RT; row += NGW) {
        const u32x2 a = *((const u32x2*)(CQKV + (size_t)row * 512) + lane);
        float sq = bf_lo(a.x) * bf_lo(a.x) + bf_hi(a.x) * bf_hi(a.x) + bf_lo(a.y) * bf_lo(a.y) + bf_hi(a.y) * bf_hi(a.y);
        float sk = 0.f;
        if (lane < 32) { const u32x2 b = *((const u32x2*)(CQKV + (size_t)row * 512 + 256) + lane); sk = bf_lo(b.x) * bf_lo(b.x) + bf_hi(b.x) * bf_hi(b.x) + bf_lo(b.y) * bf_lo(b.y) + bf_hi(b.y) * bf_hi(b.y); }
        sq = wave_sum_dpp(sq); sk = wave_sum(sk);
        if (lane == 0) { rq[row] = rsqrtf(sq * (1.0f / 256.0f) + EPS); rkv[row] = rsqrtf(sk * (1.0f / 128.0f) + EPS); }
    }
}

__device__ __forceinline__ void unpack8(const u32x4 w, float* x) { x[0] = bf_lo(w.x); x[1] = bf_hi(w.x); x[2] = bf_lo(w.y); x[3] = bf_hi(w.y); x[4] = bf_lo(w.z); x[5] = bf_hi(w.z); x[6] = bf_lo(w.w); x[7] = bf_hi(w.w); }
__device__ __forceinline__ float dpp_xor1(float v) { return __builtin_bit_cast(float, __builtin_amdgcn_mov_dpp(__builtin_bit_cast(int, v), 0xB1, 0xf, 0xf, false)); }
__device__ __forceinline__ float dpp_xor2(float v) { return __builtin_bit_cast(float, __builtin_amdgcn_mov_dpp(__builtin_bit_cast(int, v), 0x4E, 0xf, 0xf, false)); }
__device__ __forceinline__ float dpp_hmirror(float v) { return __builtin_bit_cast(float, __builtin_amdgcn_mov_dpp(__builtin_bit_cast(int, v), 0x141, 0xf, 0xf, false)); }
__device__ __forceinline__ void qk_fin8(const u32x4 (&w)[3], const float (&g)[3][8], const float* cs, const float* sn, bool rope, bool second, float outscale, u32x4 (&o)[3]) {
    float x[3][8]; float ss = 0.f;
#pragma unroll
    for (int j = 0; j < 3; ++j) { unpack8(w[j], x[j]);
#pragma unroll
        for (int i = 0; i < 8; ++i) ss += x[j][i] * x[j][i]; }
    ss += dpp_xor1(ss); ss += dpp_xor2(ss); ss += dpp_hmirror(ss);
    const float r = rsqrtf(ss * (1.0f / 192.0f) + EPS);
#pragma unroll
    for (int j = 0; j < 3; ++j)
#pragma unroll
        for (int i = 0; i < 8; ++i) x[j][i] = x[j][i] * r * g[j][i];
    float pr[8];
#pragma unroll
    for (int i = 0; i < 8; ++i) pr[i] = dpp_xor2(x[2][i]);
    if (rope) {
#pragma unroll
        for (int i = 0; i < 8; ++i) x[2][i] = second ? (pr[i] * sn[i] + x[2][i] * cs[i]) : (x[2][i] * cs[i] - pr[i] * sn[i]);
    }
#pragma unroll
    for (int j = 0; j < 3; ++j) { o[j].x = pk2(x[j][0] * outscale, x[j][1] * outscale); o[j].y = pk2(x[j][2] * outscale, x[j][3] * outscale); o[j].z = pk2(x[j][4] * outscale, x[j][5] * outscale); o[j].w = pk2(x[j][6] * outscale, x[j][7] * outscale); }
}
__device__ __forceinline__ void finalize_phase(bf16* Qb_, bf16* Kb_, const bf16* CQKV_, const float* gq, const float* gk, const float* ropetab, bool need_qc, int gw, int NGW, int lane) {
    GAS bf16* Kb = (GAS bf16*)Kb_; const GAS bf16* CQKV = (const GAS bf16*)CQKV_; const GAS float* rt = (const GAS float*)ropetab;
    const int l8 = lane & 7, head = lane >> 3;
    float gkv[3][8];
#pragma unroll
    for (int j = 0; j < 3; ++j)
#pragma unroll
        for (int i = 0; i < 8; ++i) gkv[j][i] = gk[(l8 + 8 * j) * 8 + i];
    const int axis = (l8 >= 4) ? 1 : 0, f0 = 8 * (l8 & 1); const bool second = (l8 & 2) != 0;
    for (int row0 = gw; row0 < RT; row0 += 4 * NGW) {
        u32x4 kw[4][3]; f32x4 cc[4][4];
#pragma unroll
        for (int q = 0; q < 4; ++q) { const int row = (row0 + q * NGW < RT) ? row0 + q * NGW : row0; const int t = row < RL ? (row & (SEQ - 1)) : 0;
            const GAS float* ct = rt + ((size_t)t * 2 + axis) * 16 + f0; const size_t o0 = (size_t)row * 1536 + head * 192 + l8 * 8;
            cc[q][0] = *(const GAS f32x4*)ct; cc[q][1] = *(const GAS f32x4*)(ct + 4); cc[q][2] = *(const GAS f32x4*)(ct + SEQ * 32); cc[q][3] = *(const GAS f32x4*)(ct + SEQ * 32 + 4);
            kw[q][0] = *(const GAS u32x4*)(Kb + o0); kw[q][1] = *(const GAS u32x4*)(Kb + o0 + 64); kw[q][2] = *(const GAS u32x4*)(CQKV + (size_t)row * 512 + 384 + l8 * 8); }
#pragma unroll
        for (int q = 0; q < 4; ++q) { const int row = row0 + q * NGW; if (row < RT) {
            const float cs[8] = {cc[q][0].x, cc[q][0].y, cc[q][0].z, cc[q][0].w, cc[q][1].x, cc[q][1].y, cc[q][1].z, cc[q][1].w}, sn[8] = {cc[q][2].x, cc[q][2].y, cc[q][2].z, cc[q][2].w, cc[q][3].x, cc[q][3].y, cc[q][3].z, cc[q][3].w};
            u32x4 ov[3]; qk_fin8(kw[q], gkv, cs, sn, row < RL, second, 1.0f, ov);
            const size_t o0 = (size_t)row * 1536 + head * 192 + l8 * 8;
#pragma unroll
            for (int j = 0; j < 3; ++j) *(GAS u32x4*)(Kb + o0 + 64 * j) = ov[j]; } }
    }
}

__device__ __forceinline__ void conv_phase(const bf16* Bb_, const bf16* Vb_, const float* cw, bf16* Y_, int gtid, int NT_) {
    const GAS bf16* Bb = (const GAS bf16*)Bb_; const GAS bf16* Vb = (const GAS bf16*)Vb_; GAS bf16* Y = (GAS bf16*)Y_;
    const int c8 = (gtid & 127) * 8;
    float w0[8], w1[8], w2[8];
#pragma unroll
    for (int i = 0; i < 8; ++i) { w0[i] = cw[c8 + i]; w1[i] = cw[D + c8 + i]; w2[i] = cw[2 * D + c8 + i]; }
    for (int it0 = gtid; it0 < RT * 128; it0 += 4 * NT_) {
        u32x4 lb[4], l0[4], l1[4], l2[4]; float m0[4], m2[4];
#pragma unroll
        for (int q = 0; q < 4; ++q) { const int it = (it0 + q * NT_ < RT * 128) ? it0 + q * NT_ : it0;
            const int row = it >> 7;
            const int pos = row < RL ? (row & (SEQ - 1)) : ((row - RL) & (CTXL - 1)); const int len = row < RL ? SEQ : CTXL;
            const size_t off = (size_t)row * D + c8; const bool hp = pos > 0, hn = pos < len - 1;
            lb[q] = *(const GAS u32x4*)(Bb + off); l1[q] = *(const GAS u32x4*)(Vb + off);
            l0[q] = *(const GAS u32x4*)(Vb + (hp ? off - D : off)); l2[q] = *(const GAS u32x4*)(Vb + (hn ? off + D : off));
            m0[q] = hp ? 1.f : 0.f; m2[q] = hn ? 1.f : 0.f; }
#pragma unroll
        for (int q = 0; q < 4; ++q) { const int it = it0 + q * NT_; if (it < RT * 128) {
            const int row = it >> 7; const size_t off = (size_t)row * D + c8;
            float b[8], v0[8], v1[8], v2[8], y[8];
            unpack8(lb[q], b); unpack8(l0[q], v0); unpack8(l1[q], v1); unpack8(l2[q], v2);
#pragma unroll
            for (int i = 0; i < 8; ++i) y[i] = b[i] * (w0[i] * m0[q] * v0[i] + w1[i] * v1[i] + w2[i] * m2[q] * v2[i]);
            u32x4 o; o.x = pk2(y[0], y[1]); o.y = pk2(y[2], y[3]); o.z = pk2(y[4], y[5]); o.w = pk2(y[6], y[7]);
            *(GAS u32x4*)(Y + off) = o; } }
    }
}

#define XB_TMO      128
#define XB_XCNT(j)  (256  + 64 * (j))
#define XB_XSUB(j)  (1280 + 64 * (j))
#define XB_XGEN(j)  (2304 + 64 * (j))
#define XB_TOP      3328
#define XB_TOPGEN   3392
#define XCD_BAR_WORDS 3456
#define XB_SPIN_CAP (1u << 18)

__device__ __forceinline__ unsigned xb_ld(unsigned* p)              { return __hip_atomic_load(p, __ATOMIC_RELAXED, __HIP_MEMORY_SCOPE_AGENT); }
__device__ __forceinline__ unsigned xb_add(unsigned* p, unsigned v) { return __hip_atomic_fetch_add(p, v, __ATOMIC_RELAXED, __HIP_MEMORY_SCOPE_AGENT); }
__device__ __forceinline__ unsigned xb_xcc_id() { return (unsigned)__builtin_amdgcn_s_getreg((3 << 11) | 20) & 0xFu; }
#define XB_SPIN(cond, bar) do { unsigned _sp = 0; while (cond) { __builtin_amdgcn_s_sleep(1); \
    if ((++_sp & 255u) == 0u) { if (xb_ld(&(bar)[XB_TMO])) break; if (_sp > XB_SPIN_CAP) { atomicAdd(&(bar)[XB_TMO], 1u); break; } } } } while (0)

struct XcdBarrier {
    unsigned* bar; unsigned x;
    volatile LAS unsigned* st;
};

__device__ __forceinline__ XcdBarrier xcd_barrier_post(unsigned* bar, volatile LAS unsigned* st) {
    XcdBarrier b; b.bar = bar; b.x = xb_xcc_id(); b.st = st;
    if (threadIdx.x == 0) (void)xb_add(&bar[XB_XCNT(b.x)], 1u);
    return b;
}
__device__ __forceinline__ void xcd_barrier_complete(unsigned* bar, unsigned x, unsigned& nloc, unsigned& nx) {
    const unsigned G = gridDim.x * gridDim.y * gridDim.z;
    unsigned sum, cnt, mine, sp = 0u;
    for (;;) {
        sum = 0u; cnt = 0u; mine = 0u;
#pragma unroll
        for (unsigned j = 0; j < 16; ++j) { const unsigned c = xb_ld(&bar[XB_XCNT(j)]); sum += c; cnt += (c > 0u) ? 1u : 0u; mine = (j == x) ? c : mine; }
        if (sum == G) break;
        __builtin_amdgcn_s_sleep(1);
        if ((++sp & 255u) == 0u) { if (xb_ld(&bar[XB_TMO])) break; if (sp > XB_SPIN_CAP) { atomicAdd(&bar[XB_TMO], 1u); break; } }
    }
    nloc = mine > 0u ? mine : 1u; nx = cnt > 0u ? cnt : 1u;
}

__device__ __forceinline__ void xcd_barrier(const XcdBarrier& b) {
    asm volatile("s_waitcnt vmcnt(0)" ::: "memory");
    __syncthreads();
    if (threadIdx.x == 0) {
        unsigned* bar = b.bar;
        __builtin_amdgcn_s_waitcnt(0);
        unsigned nloc = b.st[0], nx = b.st[1];
        if (nloc == 0u) { xcd_barrier_complete(bar, b.x, nloc, nx); b.st[0] = nloc; b.st[1] = nx; }
        const unsigned old = xb_add(&bar[XB_XSUB(b.x)], 1u);
        const unsigned gen = old / nloc;
        if (old + 1u == (gen + 1u) * nloc) {
            __builtin_amdgcn_fence(__ATOMIC_RELEASE, "agent");
            asm volatile("s_waitcnt vmcnt(0)" ::: "memory");
            const unsigned og = xb_add(&bar[XB_TOP], 1u);
            const unsigned tg = og / nx;
            if (og + 1u == (tg + 1u) * nx) xb_add(&bar[XB_TOPGEN], 1u);
            else XB_SPIN(xb_ld(&bar[XB_TOPGEN]) == tg, bar);
            __builtin_amdgcn_fence(__ATOMIC_ACQUIRE, "agent");
            xb_add(&bar[XB_XGEN(b.x)], 1u);
            asm volatile("s_waitcnt vmcnt(0)" ::: "memory");
        } else {
            XB_SPIN(xb_ld(&bar[XB_XGEN(b.x)]) == gen, bar);
            __builtin_amdgcn_fence(__ATOMIC_ACQUIRE, "agent");
            asm volatile("s_waitcnt vmcnt(0)" ::: "memory");
        }
    }
    __syncthreads();
}


typedef pg8::GemmT<D, DFF, DFF> GemmDn; typedef pg8::GemmT<D, D, D> GemmSq; typedef pg8::GemmT<D, 1536, 1536> GemmWo;
#define GSYNC() do { XcdBarrier b_; b_.bar = (unsigned*)(ldws() + OFF_CTL); b_.x = xb_xcc_id(); b_.st = (volatile LAS unsigned*)(uintptr_t)MISC_OFF; xcd_barrier(b_); } while (0)
__global__ void __launch_bounds__(NWAVES * 64) fwd_megakernel(Params p) {
    extern __shared__ __attribute__((aligned(16))) unsigned char lds_raw[];
    cg::grid_group grid = cg::this_grid();
    LAS unsigned char* lds = (LAS unsigned char*)lds_raw;
    const int tid = threadIdx.x, lane = tid & 63, wave = __builtin_amdgcn_readfirstlane(tid >> 6);
    if (tid == 0) {
        volatile LAS unsigned long long* t = (volatile LAS unsigned long long*)(uintptr_t)PTAB_OFF;
#pragma unroll
        for (int i = 0; i < N_IN; ++i) t[i] = (unsigned long long)p.in[i];
        t[I_OUT] = (unsigned long long)p.out; t[I_WS] = (unsigned long long)p.ws;
        volatile LAS unsigned* m = (volatile LAS unsigned*)(uintptr_t)MISC_OFF; m[0] = 0u; m[1] = 0u;
    }
    __syncthreads();
    (void)xcd_barrier_post((unsigned*)(p.ws + OFF_CTL), (volatile LAS unsigned*)(uintptr_t)MISC_OFF);
    if (p.pad0 != 0) grid.sync();
#define BX() ({ int b_ = blockIdx.x; asm volatile("" : "+s"(b_)); b_; })
#define GD() ({ int g_ = gridDim.x; asm volatile("" : "+s"(g_)); g_; })
#define GW (BX() * NWAVES + wave)
#define NGW_ (GD() * NWAVES)

    {
        const int G = GD(), bx = BX();
#ifndef NO_MOD
        for (int g = bx; g < 144; g += G) mod_group(g, lds, tid, wave, lane);
#endif
        unsigned char* ws = ldws(); float* ROPE = (float*)(ws + OFF_ROPE);
        for (int i = bx * 512 + tid; i < SEQ * 32; i += G * 512) { const int t = i >> 5, axis = (i >> 4) & 1, f = i & 15; const float pos = (float)(axis ? (t & 63) : (t >> 6));
            const float inv = exp2f(-(float)f * (13.287712379549449f / 16.0f)); const float a = pos * inv; ROPE[i] = cosf(a); ROPE[SEQ * 32 + i] = sinf(a); }
        for (int i = bx * 512 + tid; i < 2 * 64 * 128; i += G * 512) { const int j = i / (64 * 128), r = (i / 128) % 64, c = i % 128; *(u32x4*)((bf16*)(ws + OFF_WA + j * SZ_WA) + (size_t)(448 + r) * 1024 + c * 8) = (u32x4){0u, 0u, 0u, 0u}; }
        for (int i = bx * 512 + tid; i < 2 * 1024 * 64; i += G * 512) { const int j = i >> 16, r = (i >> 6) & 1023, h = (i >> 3) & 7, c = i & 7; *(u32x4*)((bf16*)(ws + OFF_WO + j * SZ_WO) + (size_t)r * 1536 + h * 192 + 128 + c * 8) = (u32x4){0u, 0u, 0u, 0u}; }
        LAS float* scr = (LAS float*)(lds + wave * 16384);
        for (int it = GW; it < IT_END; it += NGW_) convert_item(it, scr, lane);
    }
    GSYNC();
    {
        int tidv = threadIdx.x; asm volatile("" : "+v"(tidv));
        const int tid2 = tidv, lane2 = tid2 & 63, wave2 = __builtin_amdgcn_readfirstlane(tid2 >> 6);
        for (int u = BX(); u < 408; u += GD()) bias_unit(u, lds, tid2, wave2, lane2);
        unsigned char* ws = ldws();
        first_aprime(ldp(I_X), ldp(I_CTX), ldp(I_GNORM), (const float*)(ws + OFF_MOD) + D, (bf16*)(ws + OFF_NH), (float*)(ws + OFF_SS), BX() * NWAVES + wave2, NGW_, lane2);
    }
    GSYNC();

#pragma unroll 1
    for (int it = 0; it < 3 * DEPTH; ++it) {
        {
            int itv = it; asm volatile("" : "+s"(itv));
            int tidv = threadIdx.x; asm volatile("" : "+v"(tidv));
            const int tid = tidv, lane = tid & 63, wave = __builtin_amdgcn_readfirstlane(tid >> 6);
            const int l = itv / 3, s = itv - 3 * l;
            const int kind = l & 1, j = l >> 1; const bool last = (l == DEPTH - 1);
            unsigned char* const ws = ldws();
            const int rows_out = (last && s >= 1) ? RL : RT;
            const float* SSc = (const float*)(ws + OFF_SS);
            if (s != 1) {
                const int m = l * 2 + (s >> 1);
                pg8::GemmT<2 * DFF, D, D> g{(const bf16*)(ws + OFF_NH), (const bf16*)(ws + OFF_WUP + m * SZ_WUP), rows_out}; pg8::StaticOrder S; S.init(rows_out, 2 * DFF, GD(), BX());
                pg8::EpiSwiGLU E{(bf16*)(ws + OFF_ACT), DFF, SSc, (const float*)(ws + OFF_BIAS) + BIAS_UP + (size_t)m * 17 * 5632};
                pg8::gemm_phase<pg8::EpiSwiGLU, pg8::StaticOrder, true, true>(lds, g, S, E);
                GSYNC();
            } else if (kind == 0) {
                { pg8::GemmT<3072, D, D> g{(const bf16*)(ws + OFF_NH), (const bf16*)(ws + OFF_WIN + j * SZ_WIN), rows_out}; pg8::StaticOrder S; S.init(rows_out, 3072, GD(), BX());
                  pg8::EpiWin E{(bf16*)(ws + OFF_BB), (bf16*)(ws + OFF_VV), SSc, (const float*)(ws + OFF_BIAS) + BIAS_WIN + (size_t)j * 17 * 3072};
                  pg8::gemm_phase<pg8::EpiWin, pg8::StaticOrder, true, true>(lds, g, S, E); }
                GSYNC();
                { conv_phase((const bf16*)(ws + OFF_BB), (const bf16*)(ws + OFF_VV), ldp(I_SCCONV) + (size_t)j * 3 * D, (bf16*)(ws + OFF_YY), BX() * 512 + tid, GD() * 512); }
                GSYNC();
            } else {
                { pg8::GemmT<512, D, D> g{(const bf16*)(ws + OFF_NH), (const bf16*)(ws + OFF_WA + j * SZ_WA), RT}; pg8::StaticOrder S; S.init(RT, 512, GD(), BX());
                  pg8::EpiBf16 E{(bf16*)(ws + OFF_CQKV), 512, nullptr, SSc, (const float*)(ws + OFF_BIAS) + BIAS_WA + (size_t)j * 17 * 512, (float*)(ws + OFF_STAT)};
                  pg8::gemm_phase<pg8::EpiBf16, pg8::StaticOrder, true, true>(lds, g, S, E); }
                GSYNC();
                { const float* RS4 = (const float*)(ws + OFF_STAT);
                  pg8::GemmT<1536, 256, 512> g{(const bf16*)(ws + OFF_CQKV), (const bf16*)(ws + OFF_WUQ + j * SZ_WUQ), rows_out}; pg8::StaticOrder S; S.init(rows_out, 1536, GD(), BX());
                  pg8::EpiBf16 E{(bf16*)(ws + OFF_Q), 1536, RS4, nullptr, nullptr, nullptr};
                  pg8::gemm_phase<pg8::EpiBf16, pg8::StaticOrder, true, true>(lds, g, S, E); }
                { const float* RS4 = (const float*)(ws + OFF_STAT);
                  pg8::GemmT<2048, 128, 512> g{(const bf16*)(ws + OFF_CQKV) + 256, (const bf16*)(ws + OFF_WUKV + j * SZ_WUKV), RT}; pg8::StaticOrder S; S.init(RT, 2048, GD(), BX());
                  pg8::EpiKV E{(bf16*)(ws + OFF_K), (bf16*)(ws + OFF_V), RS4};
                  pg8::gemm_phase<pg8::EpiKV, pg8::StaticOrder, true, true>(lds, g, S, E); }
                GSYNC();
#ifndef NO_FIN
                { finalize_phase((bf16*)(ws + OFF_Q), (bf16*)(ws + OFF_K), (const bf16*)(ws + OFF_CQKV), ldp(I_GQ) + j * 192, ldp(I_GK) + j * 192, (const float*)(ws + OFF_ROPE), false, GW, NGW_, lane); }
#endif
                GSYNC();
#ifndef NO_ATTN
                { const int G = GD(), bx = BX();
                  bf16* Qb = (bf16*)(ws + OFF_Q); const bf16* Kb = (const bf16*)(ws + OFF_K); const bf16* Vb = (const bf16*)(ws + OFF_V);
                  const int vcu = (G % 8 == 0) ? (bx % 8) * (G / 8) + bx / 8 : bx;
                  const int nunits = 1024 + (last ? 0 : 128); const float* gqp = ldp(I_GQ) + j * 192; const float* ropep = (const float*)(ws + OFF_ROPE);
                  for (int u = vcu; u < nunits; u += G) {
                      int b, h, q0, nt;
                      if (u < 1024) { b = u >> 6; h = (u >> 3) & 7; q0 = b * SEQ + (u & 7) * 256; nt = 36; }
                      else { b = (u - 1024) >> 3; h = (u - 1024) & 7; q0 = RL + b * CTXL; nt = 4; }
                      att::attn_unit(Qb, Kb, Vb, Qb, q0, h, nt, 4, RL + b * CTXL, b * SEQ, (char*)lds_raw, gqp, ropep, u < 1024);
                  } }
#endif
                GSYNC();
            }
            {
                const bool first = (itv == 0); const int m = l * 2 + (s >> 1);
                float* out = (float*)ldp_raw(I_OUT); float* hctx = (float*)(ws + OFF_HCTX);
                const int nx = itv + 1, ln = nx / 3, sn = nx - 3 * ln; const bool has_next = nx < 3 * DEPTH;
                const int half = (s != 1) ? 1 : 0;
                const bool split = (rows_out == RT) && (GD() == 256);
                float* part = (float*)(ws + OFF_BIG + ((s == 1 && kind == 0) ? 216 : 200) * MiB);
                const float* hin_c = first ? ldp(I_CTX) : hctx;
                const float* gatep = (const float*)(ws + OFF_MOD) + (size_t)l * NCOND * MODW + (3 * s + 2) * D;
                const float* scnp = (const float*)(ws + OFF_MOD) + (size_t)ln * NCOND * MODW + (3 * sn + 1) * D;
                const float* gnp = has_next ? ldp(I_GNORM) + (size_t)nx * D : nullptr;
#define MAKE_RES(NTF_) pg8::EpiRes E{first ? ldp(I_X) : out, hin_c, out, hctx, gatep, half, (bf16*)(ws + OFF_NH), (float*)(ws + OFF_SS), gnp, scnp, part, (NTF_) / 4}
#define RUN_RES(GT, AP, BP) do { GT g{AP, BP, rows_out}; MAKE_RES(GT::K / 64); \
                    if (split) { pg8::SplitCtxOrder S; S.init(RL, D, GD(), BX(), GT::K / 64); pg8::gemm_phase<pg8::EpiRes, pg8::SplitCtxOrder, true, true>(lds, g, S, E); } \
                    else { pg8::StaticOrder S; S.init(rows_out, D, GD(), BX()); pg8::gemm_phase<pg8::EpiRes, pg8::StaticOrder, true, true>(lds, g, S, E); } } while (0)
                if (s != 1) RUN_RES(GemmDn, (const bf16*)(ws + OFF_ACT), (const bf16*)(ws + OFF_WDN + m * SZ_WDN));
                else if (kind == 0) RUN_RES(GemmSq, (const bf16*)(ws + OFF_YY), (const bf16*)(ws + OFF_WOUT + j * SZ_SQ));
                else RUN_RES(GemmWo, (const bf16*)(ws + OFF_Q), (const bf16*)(ws + OFF_WO + j * SZ_WO));
#undef RUN_RES
#undef MAKE_RES
                if (split) {
                    GSYNC();
                    ctx_fix(hin_c, hctx, part, gatep + (size_t)16 * MODW, half ? 0.5f : 1.0f, (bf16*)(ws + OFF_NH), (float*)(ws + OFF_SS), gnp, scnp + (size_t)16 * MODW, GW, NGW_, lane);
                }
            }
            GSYNC();
        }
    }
}

extern "C" void kernel_launch(void* const* d_in, const int* in_sizes, int n_in, void* d_out, int out_size, void* d_ws, size_t ws_size, hipStream_t stream) {
    static int grid = 0;
    if (grid == 0) {
        if (n_in != N_IN || out_size != RL * D || ws_size < WS_END) { fprintf(stderr, "kernel_launch: unexpected shapes: n_in %d out %d ws %zu (need %zu)\n", n_in, out_size, ws_size, (size_t)WS_END); grid = -1; return; }
        int dev = 0, cus = 0, per_cu = 0;
        hipGetDevice(&dev); hipDeviceGetAttribute(&cus, hipDeviceAttributeMultiprocessorCount, dev);
        if (hipFuncSetAttribute((const void*)fwd_megakernel, hipFuncAttributeMaxDynamicSharedMemorySize, LDS_BYTES) != hipSuccess) { fprintf(stderr, "kernel_launch: hipFuncSetAttribute failed\n"); grid = -1; return; }
        if (hipOccupancyMaxActiveBlocksPerMultiprocessor(&per_cu, (const void*)fwd_megakernel, NWAVES * 64, LDS_BYTES) != hipSuccess || per_cu < 1) { fprintf(stderr, "kernel_launch: occupancy query says %d\n", per_cu); per_cu = 1; }
        (void)hipGetLastError();
        grid = cus * (per_cu > 1 ? 1 : per_cu);
        fprintf(stderr, "kernel_launch: grid %d (cus %d per_cu %d) ws %zu\n", grid, cus, per_cu, ws_size);
    }
    if (grid < 0) return;
    if (hipMemsetAsync((char*)d_ws + OFF_CTL, 0, CTL_BYTES, stream) != hipSuccess) { fprintf(stderr, "kernel_launch: memset failed\n"); return; }
    Params p{};
    for (int i = 0; i < N_IN; ++i) p.in[i] = (const float*)d_in[i];
    p.out = (float*)d_out; p.ws = (unsigned char*)d_ws; p.pad0 = 0; p.pad1 = 0;
    void* args[] = {&p};
    hipError_t e = hipLaunchCooperativeKernel((const void*)fwd_megakernel, dim3(grid), dim3(NWAVES * 64), args, LDS_BYTES, stream);
    if (e != hipSuccess) fprintf(stderr, "cooperative launch failed: %s (grid %d)\n", hipGetErrorString(e), grid);
}
```

```cpp
#include <hip/hip_runtime.h>
#include <hip/hip_cooperative_groups.h>
#include <cstdio>
#include <cstdint>
namespace cg = cooperative_groups;
namespace pg8 {
#define PG8_LAS __attribute__((address_space(3)))
typedef unsigned short bf16_t;
typedef short bf16x8 __attribute__((ext_vector_type(8)));
typedef float f32x4 __attribute__((ext_vector_type(4)));
typedef unsigned u32x4 __attribute__((ext_vector_type(4)));
typedef unsigned u32x2 __attribute__((ext_vector_type(2)));
constexpr int BM = 256, BK = 64, HALF = 128, HTB = HALF * BK * 2  , STAGE_BYTES = 8 * HTB, NXCD = 8, WGM = 8;

__device__ __forceinline__ float xrow_sum(float v) {
    { auto r_ = __builtin_amdgcn_permlane16_swap(__float_as_uint(v), __float_as_uint(v), false, false); v = __uint_as_float(r_[0]) + __uint_as_float(r_[1]); }
    { auto r_ = __builtin_amdgcn_permlane32_swap(__float_as_uint(v), __float_as_uint(v), false, false); v = __uint_as_float(r_[0]) + __uint_as_float(r_[1]); }
    return v;
}
__host__ __device__ __forceinline__ int lds_byte(int r, int c) { const int st = (r >> 4) * 2 + (c >> 5), rr = r & 15, cc = c & 31, ob = rr * 64 + cc * 2; return st * 1024 + (ob ^ (((ob >> 9) & 1) << 5)); }
__host__ __device__ __forceinline__ void stage_rc(int b, int& R, int& C) { const int st = b / 1024, sb = b % 1024, swz = sb ^ (((sb >> 9) & 1) << 5); R = (st >> 1) * 16 + swz / 64; C = (st & 1) * 32 + (swz % 64) / 2; }
__host__ __device__ __forceinline__ int perm32(int rho) { const int n = rho >> 4, i = rho & 15; return 8 * (i >> 2) + 4 * n + (i & 3); }

struct Unit { int pm, pn, k0, nt; };
template <int N_, int K_, int LDA_> struct GemmT { const bf16_t* A; const bf16_t* Bt; int M; static constexpr int N = N_, K = K_, lda = LDA_; };

struct StaticOrder {
    int nM, nN, nwg, G, c;
    __host__ __device__ void init(int M, int N, int G_, int c_) { nM = M / BM; nN = N / BM; nwg = nM * nN; G = G_; c = c_; }
    __host__ __device__ bool next(int i, Unit& u) const {
        const long L = (long)i * G + c; if (L >= nwg) return false;
        int wgid = (int)L; { const int q = nwg / NXCD, r = nwg % NXCD, xcd = wgid % NXCD, off = wgid / NXCD; wgid = (xcd < r ? xcd * (q + 1) : r * (q + 1) + (xcd - r) * q) + off; }
        const int nig = WGM * nN, gid = wgid / nig, fm = gid * WGM, gsz = (nM - fm) < WGM ? (nM - fm) : WGM;
        u.pm = fm + ((wgid % nig) % gsz); u.pn = (wgid % nig) / gsz; u.k0 = 0; u.nt = 0; return true;
    }
    __device__ __forceinline__ void a_ready(const Unit&) const {}
    __device__ __forceinline__ void done(const Unit&) const {}
};


struct SplitCtxOrder {
    StaticOrder lat; int c, ntf;
    __host__ __device__ void init(int Mlat, int N, int G_, int c_, int ntf_) { lat.init(Mlat, N, G_, c_); c = c_; ntf = ntf_; }
    __host__ __device__ bool next(int i, Unit& u) const {
        if (i < 2) return lat.next(i, u);
        if (i > 2) return false;
        const int cu = c >> 2, kq = c & 3, base = ntf >> 2, odd = base & 1;
        u.pm = 128 + (cu >> 2); u.pn = cu & 3;
        u.k0 = kq * base + (odd ? (kq & 1) : 0); u.nt = base + (odd ? ((kq & 1) ? -1 : 1) : 0);
        return true;
    }
    __device__ __forceinline__ void a_ready(const Unit&) const {}
    __device__ __forceinline__ void done(const Unit&) const {}
};
__device__ __forceinline__ unsigned cvt_pk_bf16(float lo, float hi) { unsigned r; asm volatile("v_cvt_pk_bf16_f32 %0, %1, %2" : "=v"(r) : "v"(lo), "v"(hi)); return r; }
__device__ __forceinline__ u32x4 pack8(const f32x4 v0, const f32x4 v1) { u32x4 w; w.x = cvt_pk_bf16(v0[0], v0[1]); w.y = cvt_pk_bf16(v0[2], v0[3]); w.z = cvt_pk_bf16(v1[0], v1[1]); w.w = cvt_pk_bf16(v1[2], v1[3]); return w; }
__device__ __forceinline__ float silu_f(float a) { return a * __builtin_amdgcn_rcpf(1.0f + __builtin_amdgcn_exp2f(-1.4426950408889634f * a)); }

#define PG8_GAS __attribute__((address_space(1)))
constexpr int RL_ROWS = 32768;
__device__ __forceinline__ float row_rs(const float* ssp, int row) { const PG8_GAS f32x4* p = (const PG8_GAS f32x4*)(ssp + (size_t)row * 16); const f32x4 a = p[0], b = p[1], c = p[2], d = p[3];
    const float s = ((a[0] + a[1]) + (a[2] + a[3])) + ((b[0] + b[1]) + (b[2] + b[3])) + (((c[0] + c[1]) + (c[2] + c[3])) + ((d[0] + d[1]) + (d[2] + d[3]))); return rsqrtf(s * (1.0f / 1024.0f) + 1e-6f); }

constexpr int RS_LDS_OFF = 131072;
__device__ __forceinline__ void tile_rs_build(const float* ss, int rowt, int wr, int wc, int fr, int fq) {
    const int t = (wr * 4 + wc) * 64 + fq * 16 + fr;
    if (t < 256) ((PG8_LAS float*)(uintptr_t)RS_LDS_OFF)[t] = row_rs(ss, rowt + t);
    asm volatile("s_waitcnt lgkmcnt(0)" ::: "memory"); __builtin_amdgcn_s_barrier(); asm volatile("" ::: "memory");
}
__device__ __forceinline__ float tile_rs(int rloc) { return ((const PG8_LAS float*)(uintptr_t)RS_LDS_OFF)[rloc]; }
struct EpiSwiGLU {
    static constexpr bool PERM = true, AFTER_DRAIN = false;
    bf16_t* O; int ldc; const float* ss; const float* bias;
    __device__ __forceinline__ void operator()(const f32x4 (&acc)[2][2][4][2], const Unit& u, int wr, int wc, int fr, int fq) const {
        const int rowt = u.pm * BM, cond = rowt < RL_ROWS ? (rowt >> 11) : 16;
        const int row0 = rowt + wr * 64 + fr, col0 = u.pn * HALF + wc * 32 + 8 * fq;
        const float* bp = bias + (size_t)cond * (2 * ldc) + u.pn * BM + wc * 32 + 8 * fq;
        f32x4 bv[2][2];
#pragma unroll
        for (int bj = 0; bj < 2; ++bj)
#pragma unroll
            for (int n = 0; n < 2; ++n) bv[bj][n] = *(const f32x4*)(bp + bj * HALF + 4 * n);
        tile_rs_build(ss, rowt, wr, wc, fr, fq);
#pragma unroll
        for (int ai = 0; ai < 2; ++ai)
#pragma unroll
            for (int m = 0; m < 4; ++m) { const int row = row0 + ai * HALF + m * 16; const float rs = tile_rs(row - rowt); bf16_t* rowp = O + (size_t)row * ldc + col0;
                f32x4 v0, v1;
#pragma unroll
                for (int j = 0; j < 4; ++j) { v0[j] = silu_f(acc[ai][0][m][0][j] * rs + bv[0][0][j]) * (acc[ai][1][m][0][j] * rs + bv[1][0][j]); v1[j] = silu_f(acc[ai][0][m][1][j] * rs + bv[0][1][j]) * (acc[ai][1][m][1][j] * rs + bv[1][1][j]); }
                *(PG8_GAS u32x4*)rowp = pack8(v0, v1); }
    }
};
struct EpiBf16 {
    static constexpr bool PERM = true, AFTER_DRAIN = false;
    bf16_t* O; int ldc; const float* rs4; const float* ss; const float* bias; float* sqout;
    __device__ __forceinline__ void operator()(const f32x4 (&acc)[2][2][4][2], const Unit& u, int wr, int wc, int fr, int fq) const {
        const int rowt = u.pm * BM, cond = rowt < RL_ROWS ? (rowt >> 11) : 16;
        const int row0 = rowt + wr * 64 + fr, col0 = u.pn * BM + wc * 32 + 8 * fq;
        f32x4 bv[2][2];
#pragma unroll
        for (int bj = 0; bj < 2; ++bj)
#pragma unroll
            for (int n = 0; n < 2; ++n) bv[bj][n] = bias ? *(const f32x4*)(bias + (size_t)cond * ldc + col0 + bj * HALF + 4 * n) : (f32x4){0.f, 0.f, 0.f, 0.f};
        if (!rs4) tile_rs_build(ss, rowt, wr, wc, fr, fq);
#pragma unroll
        for (int ai = 0; ai < 2; ++ai)
#pragma unroll
            for (int m = 0; m < 4; ++m) { const int row = row0 + ai * HALF + m * 16; float s;
                if (rs4) { const f32x4 p = *(const PG8_GAS f32x4*)(rs4 + (size_t)row * 8); s = rsqrtf(((p[0] + p[1]) + (p[2] + p[3])) * (1.0f / 256.0f) + 1e-6f); } else s = tile_rs(row - rowt);
                bf16_t* rowp = O + (size_t)row * ldc + col0; float sq = 0.f;
#pragma unroll
                for (int bj = 0; bj < 2; ++bj) { const f32x4 v0 = acc[ai][bj][m][0] * s + bv[bj][0], v1 = acc[ai][bj][m][1] * s + bv[bj][1]; *(PG8_GAS u32x4*)(rowp + bj * HALF) = pack8(v0, v1);
                    if (bj == 0 || u.pn == 0) sq += ((v0[0] * v0[0] + v0[1] * v0[1]) + (v0[2] * v0[2] + v0[3] * v0[3])) + ((v1[0] * v1[0] + v1[1] * v1[1]) + (v1[2] * v1[2] + v1[3] * v1[3])); }
                if (sqout) { sq = xrow_sum(sq); if (fq == 0 && u.pn < 2) sqout[(size_t)row * 8 + u.pn * 4 + wc] = sq; } }
    }
};
struct EpiKV {
    static constexpr bool PERM = true, AFTER_DRAIN = false;
    bf16_t* Kb; bf16_t* Vb; const float* rs4;
    __device__ __forceinline__ void operator()(const f32x4 (&acc)[2][2][4][2], const Unit& u, int wr, int wc, int fr, int fq) const {
        const int row0 = u.pm * BM + wr * 64 + fr, c0 = wc * 32 + 8 * fq;
#pragma unroll
        for (int ai = 0; ai < 2; ++ai)
#pragma unroll
            for (int m = 0; m < 4; ++m) { const int row = row0 + ai * HALF + m * 16; const f32x4 p = *(const PG8_GAS f32x4*)(rs4 + (size_t)row * 8 + 4); const float s = rsqrtf(((p[0] + p[1]) + (p[2] + p[3])) * (1.0f / 128.0f) + 1e-6f);
                *(PG8_GAS u32x4*)(Kb + (size_t)row * 1536 + u.pn * 192 + c0) = pack8(acc[ai][0][m][0] * s, acc[ai][0][m][1] * s);
                *(PG8_GAS u32x4*)(Vb + (size_t)row * 1024 + u.pn * 128 + c0) = pack8(acc[ai][1][m][0] * s, acc[ai][1][m][1] * s); }
    }
};
struct EpiWin {
    static constexpr bool PERM = true, AFTER_DRAIN = false;
    bf16_t* Bb; bf16_t* Vb; const float* ss; const float* bias;
    __device__ __forceinline__ void operator()(const f32x4 (&acc)[2][2][4][2], const Unit& u, int wr, int wc, int fr, int fq) const {
        const int rowt = u.pm * BM, cond = rowt < RL_ROWS ? (rowt >> 11) : 16;
        const int row0 = rowt + wr * 64 + fr, c0 = wc * 32 + 8 * fq;
        const float* bp = bias + (size_t)cond * 3072 + u.pn * BM + c0;
        f32x4 bv[2][2];
#pragma unroll
        for (int bj = 0; bj < 2; ++bj)
#pragma unroll
            for (int n = 0; n < 2; ++n) bv[bj][n] = *(const f32x4*)(bp + bj * HALF + 4 * n);
        tile_rs_build(ss, rowt, wr, wc, fr, fq);
        if (u.pn < 4) {
#pragma unroll
            for (int ai = 0; ai < 2; ++ai)
#pragma unroll
                for (int m = 0; m < 4; ++m) { const int row = row0 + ai * HALF + m * 16; const float rs = tile_rs(row - rowt); bf16_t* rowp = Bb + (size_t)row * 1024 + u.pn * BM + c0;
#pragma unroll
                    for (int bj = 0; bj < 2; ++bj) *(PG8_GAS u32x4*)(rowp + bj * HALF) = pack8(acc[ai][bj][m][0] * rs + bv[bj][0], acc[ai][bj][m][1] * rs + bv[bj][1]); }
        } else {
#pragma unroll
            for (int ai = 0; ai < 2; ++ai)
#pragma unroll
                for (int m = 0; m < 4; ++m) { const int row = row0 + ai * HALF + m * 16; const float rs = tile_rs(row - rowt); bf16_t* rowp = Vb + (size_t)row * 1024 + (u.pn - 4) * HALF + c0;
                    *(PG8_GAS u32x4*)rowp = pack8((acc[ai][0][m][0] * rs + bv[0][0]) * (acc[ai][1][m][0] * rs + bv[1][0]), (acc[ai][0][m][1] * rs + bv[0][1]) * (acc[ai][1][m][1] * rs + bv[1][1])); }
        }
    }
};
struct EpiRes {
    static constexpr bool PERM = false, AFTER_DRAIN = false;
    const float* hin_l; const float* hin_c; float* hout_l; float* hout_c; const float* gate;   int half;
    bf16_t* NHn; float* SSn; const float* gn; const float* scn;
    float* part; int kbase;
    __device__ __forceinline__ void operator()(const f32x4 (&acc)[2][2][4][2], const Unit& u, int wr, int wc, int fr, int fq) const {
        if (u.nt != 0) {
            PG8_GAS bf16_t* pp = (PG8_GAS bf16_t*)((bf16_t*)part + ((size_t)(u.k0 / kbase) * 4096 + (size_t)(u.pm * BM - RL_ROWS)) * 1024); const unsigned o0 = (unsigned)((wr * 64 + fr) * 1024 + u.pn * BM + wc * 32 + 4 * fq);
#pragma unroll
            for (int ai = 0; ai < 2; ++ai)
#pragma unroll
                for (int m = 0; m < 4; ++m)
#pragma unroll
                    for (int bj = 0; bj < 2; ++bj)
#pragma unroll
                        for (int n = 0; n < 2; ++n) { const f32x4 a_ = acc[ai][bj][m][n]; u32x2 w_; w_.x = cvt_pk_bf16(a_[0], a_[1]); w_.y = cvt_pk_bf16(a_[2], a_[3]); *(PG8_GAS u32x2*)(pp + o0 + (unsigned)((ai * HALF + m * 16) * 1024 + bj * HALF + n * 16)) = w_; }
            return;
        }
        const int rowt = u.pm * BM; const bool lat = rowt < RL_ROWS; const int cond = lat ? (rowt >> 11) : 16;
        const PG8_GAS float* hi = (const PG8_GAS float*)(lat ? hin_l + (size_t)rowt * 1024 : hin_c + (size_t)(rowt - RL_ROWS) * 1024);
        PG8_GAS float* ho = (PG8_GAS float*)(lat ? hout_l + (size_t)rowt * 1024 : hout_c + (size_t)(rowt - RL_ROWS) * 1024);
        PG8_GAS bf16_t* nht = (PG8_GAS bf16_t*)(NHn + (size_t)rowt * 1024); PG8_GAS float* sst = (PG8_GAS float*)(SSn + (size_t)rowt * 16);
        const int col0 = u.pn * BM + wc * 32 + 4 * fq; const float* gp = gate + (size_t)cond * 9216 + col0;
        f32x4 gv[2][2], gsv[2][2]; const float gs = half ? 0.5f : 1.0f; const bool nxt = gn != nullptr;
#pragma unroll
        for (int bj = 0; bj < 2; ++bj)
#pragma unroll
            for (int n = 0; n < 2; ++n) { gv[bj][n] = *(const f32x4*)(gp + bj * HALF + n * 16) * gs;
                gsv[bj][n] = nxt ? *(const f32x4*)(gn + col0 + bj * HALF + n * 16) * (*(const f32x4*)(scn + (size_t)cond * 9216 + col0 + bj * HALF + n * 16) + 1.0f) : (f32x4){0.f, 0.f, 0.f, 0.f}; }
        const unsigned off0 = (unsigned)((wr * 64 + fr) * 1024 + col0);
#pragma unroll
        for (int g2 = 0; g2 < 4; ++g2) {
            const int ai = g2 >> 1, mb = (g2 & 1) * 2;
            f32x4 pre[2][2][2];
#pragma unroll
            for (int mm = 0; mm < 2; ++mm)
#pragma unroll
                for (int bj = 0; bj < 2; ++bj)
#pragma unroll
                    for (int n = 0; n < 2; ++n) pre[mm][bj][n] = *(const PG8_GAS f32x4*)(hi + off0 + (unsigned)((ai * HALF + (mb + mm) * 16) * 1024 + bj * HALF + n * 16));
#pragma unroll
            for (int mm = 0; mm < 2; ++mm) { const int m = mb + mm; const unsigned off = off0 + (unsigned)((ai * HALF + m * 16) * 1024); float sq = 0.f;
#pragma unroll
                for (int bj = 0; bj < 2; ++bj)
#pragma unroll
                    for (int n = 0; n < 2; ++n) { const unsigned o_ = off + (unsigned)(bj * HALF + n * 16);
                        const f32x4 o = pre[mm][bj][n] + gv[bj][n] * acc[ai][bj][m][n]; *(PG8_GAS f32x4*)(ho + o_) = o;
                        if (nxt) { const f32x4 a = o * gsv[bj][n]; u32x2 w; w.x = cvt_pk_bf16(a[0], a[1]); w.y = cvt_pk_bf16(a[2], a[3]);
                            *(PG8_GAS u32x2*)(nht + o_) = w; sq += (o[0] * o[0] + o[1] * o[1]) + (o[2] * o[2] + o[3] * o[3]); } }
                if (nxt) { sq = xrow_sum(sq); if (fq == 0) sst[(size_t)(off >> 10) * 16 + u.pn * 4 + wc] = sq; } }
        }
    }
};

template <class Epi, class Sched, bool ALIGN_EPI, bool SP2, class Gm>
__device__ __forceinline__ void gemm_phase(PG8_LAS unsigned char* lds, const Gm g, const Sched& S, const Epi& E) {
    int tid = threadIdx.x; asm volatile("" : "+v"(tid));
    const int wid = __builtin_amdgcn_readfirstlane(tid >> 6), lane = tid & 63, wr = wid >> 2, wc = wid & 3, fr = lane & 15, fq = lane >> 4;
    constexpr int K = Gm::K, NTF = K / BK;
    unsigned voffA[2], voffB[2];
#pragma unroll
    for (int i = 0; i < 2; ++i) { int R, C; stage_rc(tid * 16 + i * 8192, R, C); const int Rb = Epi::PERM ? ((R & ~31) + perm32(R & 31)) : R;
        voffA[i] = (unsigned)(R * Gm::lda + C) * 2u; voffB[i] = (unsigned)(Rb * K + C) * 2u; }
    constexpr size_t kstep = (size_t)(BK * 2);
    constexpr size_t hstepA = (size_t)HALF * Gm::lda * 2, hstepB = (size_t)HALF * K * 2;
    constexpr size_t tstepA = 2 * hstepA, tstepB = 2 * hstepB;
    const unsigned ldsw = (unsigned)wid * 1024u;
    const int aoff = lds_byte(wr * 64 + fr, fq * 8), boff = lds_byte(wc * 32 + fr, fq * 8);
#define PG8_SA(b, h) (((b) * 2 + (h)) * HTB)
#define PG8_SB(b, h) ((4 + (b) * 2 + (h)) * HTB)
#define PG8_STAGE(bufoff, gbase, voff) do { _Pragma("unroll") for (int _i = 0; _i < 2; ++_i) \
        __builtin_amdgcn_global_load_lds((const unsigned*)((const char*)(gbase) + (voff)[_i]), (PG8_LAS unsigned*)(lds + (bufoff) + ldsw + _i * 8192), 16, 0, 0); } while (0)
#define PG8_LDA(dst, b, h) do { _Pragma("unroll") for (int m = 0; m < 4; ++m) _Pragma("unroll") for (int k = 0; k < 2; ++k) dst[m][k] = *(const PG8_LAS bf16x8*)(lds + PG8_SA(b, h) + aoff + m * 2048 + k * 1024); } while (0)
#define PG8_LDB(dst, b, h) do { _Pragma("unroll") for (int n = 0; n < 2; ++n) _Pragma("unroll") for (int k = 0; k < 2; ++k) dst[n][k] = *(const PG8_LAS bf16x8*)(lds + PG8_SB(b, h) + boff + n * 2048 + k * 1024); } while (0)
#define PG8_MMA(ai, bj, At, Bt) do { __builtin_amdgcn_s_setprio(1); _Pragma("unroll") for (int m = 0; m < 4; ++m) _Pragma("unroll") for (int n = 0; n < 2; ++n) _Pragma("unroll") for (int k = 0; k < 2; ++k) \
        acc[ai][bj][m][n] = __builtin_amdgcn_mfma_f32_16x16x32_bf16(Bt[n][k], At[m][k], acc[ai][bj][m][n], 0, 0, 0); __builtin_amdgcn_s_setprio(0); } while (0)
#define PG8_WAIT_V(n) asm volatile("s_waitcnt vmcnt(" #n ")" ::: "memory")
#define PG8_WAIT_L(n) asm volatile("s_waitcnt lgkmcnt(" #n ")" ::: "memory")
#define PG8_BAR __builtin_amdgcn_s_barrier()
#define PG8_SCHED __builtin_amdgcn_sched_barrier(0)
    Unit cur, nxt; int ui = 0;
    if (!S.next(0, cur)) return;
    int nt = cur.nt ? cur.nt : NTF;
    f32x4 acc[2][2][4][2];
#pragma unroll
    for (int a = 0; a < 2; ++a)
#pragma unroll
        for (int b = 0; b < 2; ++b)
#pragma unroll
            for (int m = 0; m < 4; ++m)
#pragma unroll
                for (int n = 0; n < 2; ++n) acc[a][b][m][n] = (f32x4){0.f, 0.f, 0.f, 0.f};
    bf16x8 At[4][2], B0[2][2], B1[2][2];
    const char* cA = (const char*)g.A + (size_t)cur.pm * tstepA + (size_t)cur.k0 * kstep; const char* cB = (const char*)g.Bt + (size_t)cur.pn * tstepB + (size_t)cur.k0 * kstep;
    S.a_ready(cur);
    if constexpr (SP2) {
        PG8_STAGE(PG8_SB(0, 0), cB, voffB); PG8_STAGE(PG8_SB(0, 1), cB + hstepB, voffB); PG8_STAGE(PG8_SA(0, 0), cA, voffA); PG8_STAGE(PG8_SA(0, 1), cA + hstepA, voffA);
        if (wr == 1) PG8_BAR;
        PG8_WAIT_V(2); PG8_BAR;
        PG8_STAGE(PG8_SB(1, 0), cB + kstep, voffB); PG8_STAGE(PG8_SA(1, 0), cA + kstep, voffA); PG8_STAGE(PG8_SB(1, 1), cB + hstepB + kstep, voffB);
        PG8_WAIT_V(6); PG8_BAR;
    } else {
        PG8_STAGE(PG8_SB(0, 0), cB, voffB); PG8_STAGE(PG8_SA(0, 0), cA, voffA); PG8_STAGE(PG8_SB(0, 1), cB + hstepB, voffB); PG8_STAGE(PG8_SA(0, 1), cA + hstepA, voffA);
        if (wr == 1) PG8_BAR;
        PG8_WAIT_V(4); PG8_BAR;
        PG8_STAGE(PG8_SB(1, 0), cB + kstep, voffB); PG8_STAGE(PG8_SA(1, 0), cA + kstep, voffA); PG8_STAGE(PG8_SB(1, 1), cB + hstepB + kstep, voffB);
        PG8_WAIT_V(6); PG8_BAR;
    }
    for (;;) {
        const bool has_next = S.next(ui + 1, nxt);
        const char* nA = has_next ? (const char*)g.A + (size_t)nxt.pm * tstepA + (size_t)nxt.k0 * kstep : cA; const char* nB = has_next ? (const char*)g.Bt + (size_t)nxt.pn * tstepB + (size_t)nxt.k0 * kstep : cB;
        for (int t = 0; t < nt; t += 2) {
            const bool last = (t == nt - 2);
            const char* a1 = cA + (size_t)(t + 1) * kstep;
            const char* a2 = last ? nA : cA + (size_t)(t + 2) * kstep; const char* b2 = last ? nB : cB + (size_t)(t + 2) * kstep;
            const char* a3 = a2 + kstep; const char* b3 = b2 + kstep;
            if (last && has_next) S.a_ready(nxt);
            if constexpr (SP2) {
            PG8_LDB(B0, 0, 0); PG8_LDB(B1, 0, 1); PG8_SCHED; PG8_LDA(At, 0, 0); PG8_STAGE(PG8_SA(1, 1), a1 + hstepA, voffA);
            PG8_WAIT_V(8); PG8_WAIT_L(0); PG8_BAR; PG8_MMA(0, 0, At, B0); PG8_MMA(0, 1, At, B1); PG8_BAR; PG8_SCHED;
            PG8_LDA(At, 0, 1); PG8_STAGE(PG8_SB(0, 0), b2, voffB); PG8_STAGE(PG8_SB(0, 1), b2 + hstepB, voffB); PG8_STAGE(PG8_SA(0, 0), a2, voffA);
            PG8_WAIT_V(8); PG8_WAIT_L(0); PG8_BAR; PG8_MMA(1, 0, At, B0); PG8_MMA(1, 1, At, B1); PG8_BAR; PG8_SCHED;
            PG8_LDB(B0, 1, 0); PG8_LDB(B1, 1, 1); PG8_SCHED; PG8_LDA(At, 1, 0); PG8_STAGE(PG8_SA(0, 1), a2 + hstepA, voffA);
            PG8_WAIT_V(8); PG8_WAIT_L(0); PG8_BAR; PG8_MMA(0, 0, At, B0); PG8_MMA(0, 1, At, B1); PG8_BAR; PG8_SCHED;
            PG8_LDA(At, 1, 1); PG8_STAGE(PG8_SB(1, 0), b3, voffB); PG8_STAGE(PG8_SB(1, 1), b3 + hstepB, voffB); PG8_STAGE(PG8_SA(1, 0), a3, voffA);
            PG8_WAIT_V(8); PG8_WAIT_L(0); PG8_BAR; PG8_MMA(1, 0, At, B0); PG8_MMA(1, 1, At, B1); PG8_BAR; PG8_SCHED;
            } else {
            PG8_LDB(B0, 0, 0); PG8_SCHED; PG8_LDA(At, 0, 0); PG8_STAGE(PG8_SA(1, 1), a1 + hstepA, voffA);
            PG8_WAIT_L(8); PG8_BAR; PG8_WAIT_L(0); PG8_MMA(0, 0, At, B0); PG8_BAR; PG8_SCHED;
            PG8_LDB(B1, 0, 1); PG8_STAGE(PG8_SB(0, 0), b2, voffB);
            PG8_BAR; PG8_WAIT_L(0); PG8_MMA(0, 1, At, B1); PG8_BAR;
            PG8_LDA(At, 0, 1); PG8_STAGE(PG8_SA(0, 0), a2, voffA);
            PG8_BAR; PG8_WAIT_L(0); PG8_MMA(1, 0, At, B0); PG8_BAR; PG8_SCHED;
            PG8_STAGE(PG8_SB(0, 1), b2 + hstepB, voffB);
            PG8_WAIT_V(6); PG8_BAR; PG8_MMA(1, 1, At, B1); PG8_BAR;
            PG8_LDB(B0, 1, 0); PG8_SCHED; PG8_LDA(At, 1, 0); PG8_STAGE(PG8_SA(0, 1), a2 + hstepA, voffA);
            PG8_WAIT_L(8); PG8_BAR; PG8_WAIT_L(0); PG8_MMA(0, 0, At, B0); PG8_BAR; PG8_SCHED;
            PG8_LDB(B1, 1, 1); PG8_STAGE(PG8_SB(1, 0), b3, voffB);
            PG8_BAR; PG8_WAIT_L(0); PG8_MMA(0, 1, At, B1); PG8_BAR;
            PG8_LDA(At, 1, 1); PG8_STAGE(PG8_SA(1, 0), a3, voffA);
            PG8_BAR; PG8_WAIT_L(0); PG8_MMA(1, 0, At, B0); PG8_BAR; PG8_SCHED;
            PG8_STAGE(PG8_SB(1, 1), b3 + hstepB, voffB);
            PG8_WAIT_V(6); PG8_BAR; PG8_MMA(1, 1, At, B1); PG8_BAR;
            }
        }
        if constexpr (ALIGN_EPI) { if (wr == 0) PG8_BAR; }
        if constexpr (!Epi::AFTER_DRAIN) { E(acc, cur, wr, wc, fr, fq); S.done(cur); }
        if (!has_next) break;
#pragma unroll
        for (int a = 0; a < 2; ++a)
#pragma unroll
            for (int b = 0; b < 2; ++b)
#pragma unroll
                for (int m = 0; m < 4; ++m)
#pragma unroll
                    for (int n = 0; n < 2; ++n) acc[a][b][m][n] = (f32x4){0.f, 0.f, 0.f, 0.f};
        cur = nxt; cA = nA; cB = nB; ++ui; nt = cur.nt ? cur.nt : NTF;
        if constexpr (ALIGN_EPI) { if (wr == 1) PG8_BAR; }
    }
    PG8_WAIT_V(0);
    if constexpr (!ALIGN_EPI) { if (wr == 0) PG8_BAR; }
    PG8_BAR;
    if constexpr (Epi::AFTER_DRAIN) { E.fused(acc, cur, wr, wc, fr, fq, lds, wid, lane); S.done(cur); }
#undef PG8_SA
#undef PG8_SB
#undef PG8_STAGE
#undef PG8_LDA
#undef PG8_LDB
#undef PG8_MMA
#undef PG8_WAIT_V
#undef PG8_WAIT_L
#undef PG8_BAR
#undef PG8_SCHED
}
}
namespace att {
using bf16x8 = __attribute__((ext_vector_type(8))) short;
using s16x4  = __attribute__((ext_vector_type(4))) short;
using f32x16 = __attribute__((ext_vector_type(16))) float;
using u32x4  = __attribute__((ext_vector_type(4))) unsigned;
typedef unsigned short bf16_t;
#define ATT_GAS __attribute__((address_space(1)))
constexpr int DQK = 192, DV = 128, NW = 8, QBLK = 32, KVBLK = 64;
constexpr int LDQ = 1536, LDKK = 1536, LDV = 1024, LDO = 1536;
constexpr int QREG = 6;
constexpr int SHM_V = KVBLK * DV * 2, SHM_K = KVBLK * DQK * 2, SHM_WS = NW * 64 * 4, SHM_QOFF = 2 * SHM_V + 2 * SHM_K + SHM_WS, SHM_ATTN = SHM_QOFF + NW * (12 - QREG) * 1024;
typedef float f32x4_ __attribute__((ext_vector_type(4)));
constexpr float QSCALE = 0.07216878364870322f * 1.4426950408889634f;
constexpr float THR = 8.0f;
#define KSWZ(row, colB) ((row) * 384 + ((colB) ^ (((row) & 7) << 4)))
#define SBAR() __builtin_amdgcn_sched_barrier(0)
__device__ __forceinline__ int crow(int r, int hi) { return (r & 3) + 8 * (r >> 2) + 4 * hi; }
__device__ __forceinline__ unsigned cvtpk(float lo, float hi) { unsigned r; asm volatile("v_cvt_pk_bf16_f32 %0, %1, %2" : "=v"(r) : "v"(lo), "v"(hi)); return r; }

__device__ __forceinline__ void partialSM(f32x16& p0, f32x16& p1, float& m_reg, float& mn, float& alpha) {
  float pmax = p0[0];
#pragma unroll
  for (int r = 1; r < 16; ++r) pmax = fmaxf(pmax, p0[r]);
#pragma unroll
  for (int r = 0; r < 16; ++r) pmax = fmaxf(pmax, p1[r]);
  { auto rr = __builtin_amdgcn_permlane32_swap(__float_as_uint(pmax), __float_as_uint(pmax), false, false);
    pmax = fmaxf(__uint_as_float(rr[0]), __uint_as_float(rr[1])); }
  if (__builtin_expect(__all(pmax - m_reg <= THR), 1)) { mn = m_reg; alpha = 1.f; }
  else { mn = fmaxf(m_reg, pmax); alpha = __builtin_amdgcn_exp2f(m_reg - mn); m_reg = mn; }
#pragma unroll
  for (int r = 0; r < 16; ++r) p0[r] = p0[r] - mn;
#pragma unroll
  for (int r = 0; r < 16; ++r) p1[r] = p1[r] - mn;
#pragma unroll
  for (int r = 0; r < 16; ++r) p0[r] = __builtin_amdgcn_exp2f(p0[r]);
}
__device__ __forceinline__ void finishSM(f32x16& p0, f32x16& p1, float alpha, float& l_reg, bf16x8& pa0, bf16x8& pa1, bf16x8& pa2, bf16x8& pa3) {
#pragma unroll
  for (int r = 0; r < 16; ++r) p1[r] = __builtin_amdgcn_exp2f(p1[r]);
  float ps = 0;
#pragma unroll
  for (int r = 0; r < 16; ++r) ps += p0[r];
#pragma unroll
  for (int r = 0; r < 16; ++r) ps += p1[r];
  { auto rr = __builtin_amdgcn_permlane32_swap(__float_as_uint(ps), __float_as_uint(ps), false, false);
    ps = __uint_as_float(rr[0]) + __uint_as_float(rr[1]); }
  l_reg = l_reg * alpha + ps;
#define PK4(P, BASE, OUT) do { unsigned a0 = cvtpk(P[BASE + 0], P[BASE + 1]), a1 = cvtpk(P[BASE + 2], P[BASE + 3]);   \
    unsigned b0 = cvtpk(P[BASE + 4], P[BASE + 5]), b1 = cvtpk(P[BASE + 6], P[BASE + 7]);                              \
    auto r0 = __builtin_amdgcn_permlane32_swap(a0, b0, false, false); auto r1 = __builtin_amdgcn_permlane32_swap(a1, b1, false, false); \
    u32x4 w = {r0[0], r1[0], r0[1], r1[1]}; OUT = __builtin_bit_cast(bf16x8, w); } while (0)
  PK4(p0, 0, pa0); PK4(p0, 8, pa1); PK4(p1, 0, pa2); PK4(p1, 8, pa3);
#undef PK4
}
__device__ __forceinline__ void qkt(f32x16& p0, f32x16& p1, const char* Ks, const bf16x8* qr, const char* ql, int r32, int hi) {
  p0 = f32x16{}; p1 = f32x16{};
#pragma unroll
  for (int d0 = 0; d0 < 12; ++d0) { const int cb = (d0 * 16 + hi * 8) * 2;
    bf16x8 b0 = *reinterpret_cast<const bf16x8*>(Ks + KSWZ(r32, cb));
    bf16x8 b1 = *reinterpret_cast<const bf16x8*>(Ks + KSWZ(32 + r32, cb));
    bf16x8 q;
    if (d0 < QREG) q = qr[d0]; else q = *reinterpret_cast<const bf16x8*>(ql + (d0 - QREG) * 1024);
    p0 = __builtin_amdgcn_mfma_f32_32x32x16_bf16(b0, q, p0, 0, 0, 0);
    p1 = __builtin_amdgcn_mfma_f32_32x32x16_bf16(b1, q, p1, 0, 0, 0); }
}
__device__ __forceinline__ int v_st(int k, int c) { const int kk = (k & ~0xC) | ((k & 4) << 1) | ((k & 8) >> 1); return ((kk >> 3) * 4 + (c >> 5)) * 512 + ((kk & 7) * 32 + (c & 31)) * 2; }
__device__ __forceinline__ int v_rd_base(int lane) { return ((lane & 3) << 3) | (((lane >> 2) & 3) << 6) | (((lane >> 4) & 1) << 5) | (((lane >> 5) & 1) << 8); }
constexpr int v_rd_off(int d0, int ks, int half) { return d0 * 512 + ks * 4096 + half * 2048; }
template <int OFF> __device__ __forceinline__ s16x4 tr_read(int vb) {
  s16x4 r; asm volatile("ds_read_b64_tr_b16 %0, %1 offset:%2" : "=&v"(r) : "v"(vb), "i"(OFF) : "memory"); return r;
}
template <int D0> __device__ __forceinline__ void pv_one(f32x16& od, int vb, bf16x8 pa0, bf16x8 pa1, bf16x8 pa2, bf16x8 pa3) {
  const s16x4 l0 = tr_read<v_rd_off(D0, 0, 0)>(vb), h0 = tr_read<v_rd_off(D0, 0, 1)>(vb), l1 = tr_read<v_rd_off(D0, 1, 0)>(vb), h1 = tr_read<v_rd_off(D0, 1, 1)>(vb);
  const s16x4 l2 = tr_read<v_rd_off(D0, 2, 0)>(vb), h2 = tr_read<v_rd_off(D0, 2, 1)>(vb), l3 = tr_read<v_rd_off(D0, 3, 0)>(vb), h3 = tr_read<v_rd_off(D0, 3, 1)>(vb);
  asm volatile("s_waitcnt lgkmcnt(0)" ::: "memory"); SBAR();
#define PK(L, H) (bf16x8){L[0], L[1], L[2], L[3], H[0], H[1], H[2], H[3]}
  od = __builtin_amdgcn_mfma_f32_32x32x16_bf16(pa0, PK(l0, h0), od, 0, 0, 0);
  od = __builtin_amdgcn_mfma_f32_32x32x16_bf16(pa1, PK(l1, h1), od, 0, 0, 0);
  od = __builtin_amdgcn_mfma_f32_32x32x16_bf16(pa2, PK(l2, h2), od, 0, 0, 0);
  od = __builtin_amdgcn_mfma_f32_32x32x16_bf16(pa3, PK(l3, h3), od, 0, 0, 0);
#undef PK
}
__device__ __forceinline__ void pv_d0(f32x16* o, int vb, bf16x8 pa0, bf16x8 pa1, bf16x8 pa2, bf16x8 pa3) {
  pv_one<0>(o[0], vb, pa0, pa1, pa2, pa3); pv_one<1>(o[1], vb, pa0, pa1, pa2, pa3); pv_one<2>(o[2], vb, pa0, pa1, pa2, pa3); pv_one<3>(o[3], vb, pa0, pa1, pa2, pa3);
}

__device__ __forceinline__ void attn_unit(const bf16_t* __restrict__ Qg, const bf16_t* __restrict__ Kg, const bf16_t* __restrict__ Vg, bf16_t* __restrict__ Og,
                                          int qrow0, int h, int NT, int nctx_t, int kc0, int kl0, char* lds, const float* gq, const float* ropetab, bool lat) {
  int tid = threadIdx.x; asm volatile("" : "+v"(tid));
  const int wid = tid >> 6, lane = tid & 63, r32 = lane & 31, hi = lane >> 5;
  char* V_lds = lds; char* K_lds = lds + 2 * SHM_V;
  float* ws = (float*)(lds + 2 * SHM_V + 2 * SHM_K) + wid * 64; float* li_l = ws; float* al_l = ws + 32;
  float m_reg = -1e30f, l_reg = 0; f32x16 o[4] = {}; bf16x8 qr[QREG];
  char* ql = lds + SHM_QOFF + wid * ((12 - QREG) * 1024) + lane * 16;
  const ATT_GAS bf16_t* Qw = (const ATT_GAS bf16_t*)(Qg + (size_t)(qrow0 + wid * QBLK + r32) * LDQ + h * DQK + hi * 8);
  { u32x4 qraw[12];
#pragma unroll
    for (int d0 = 0; d0 < 12; ++d0) qraw[d0] = *(const ATT_GAS u32x4*)(Qw + d0 * 16);
    float ss = 0.f;
#pragma unroll
    for (int d0 = 0; d0 < 12; ++d0) { const u32x4 w = qraw[d0];
#pragma unroll
      for (int i = 0; i < 4; ++i) { const float lo = __builtin_bit_cast(float, w[i] << 16), hi_ = __builtin_bit_cast(float, w[i] & 0xffff0000u); ss += lo * lo + hi_ * hi_; } }
    { auto rr = __builtin_amdgcn_permlane32_swap(__float_as_uint(ss), __float_as_uint(ss), false, false); ss = __uint_as_float(rr[0]) + __uint_as_float(rr[1]); }
    const float rq = rsqrtf(ss * (1.0f / 192.0f) + 1e-6f) * QSCALE;
    const ATT_GAS float* gp = (const ATT_GAS float*)gq + hi * 8;
    const int tpos = (qrow0 + wid * QBLK + r32) & 2047;
#define QUNPK(W, X) do { _Pragma("unroll") for (int i_ = 0; i_ < 4; ++i_) { X[2 * i_] = __builtin_bit_cast(float, W[i_] << 16); X[2 * i_ + 1] = __builtin_bit_cast(float, W[i_] & 0xffff0000u); } } while (0)
#define QPUT(D0, Y) do { u32x4 w_ = {cvtpk(Y[0], Y[1]), cvtpk(Y[2], Y[3]), cvtpk(Y[4], Y[5]), cvtpk(Y[6], Y[7])}; const bf16x8 f_ = __builtin_bit_cast(bf16x8, w_); \
      if ((D0) < QREG) qr[(D0) < QREG ? (D0) : 0] = f_; else *reinterpret_cast<bf16x8*>(ql + ((D0) - QREG) * 1024) = f_; } while (0)
#pragma unroll
    for (int d0 = 0; d0 < 8; ++d0) { float x[8]; QUNPK(qraw[d0], x); const f32x4_ g0 = *(const ATT_GAS f32x4_*)(gp + d0 * 16), g1 = *(const ATT_GAS f32x4_*)(gp + d0 * 16 + 4);
#pragma unroll
      for (int i = 0; i < 4; ++i) { x[i] = x[i] * rq * g0[i]; x[4 + i] = x[4 + i] * rq * g1[i]; }
      QPUT(d0, x); }
#pragma unroll
    for (int ax = 0; ax < 2; ++ax) { float x1[8], x2[8]; QUNPK(qraw[8 + 2 * ax], x1); QUNPK(qraw[9 + 2 * ax], x2);
      const f32x4_ ga0 = *(const ATT_GAS f32x4_*)(gp + (8 + 2 * ax) * 16), ga1 = *(const ATT_GAS f32x4_*)(gp + (8 + 2 * ax) * 16 + 4), gb0 = *(const ATT_GAS f32x4_*)(gp + (9 + 2 * ax) * 16), gb1 = *(const ATT_GAS f32x4_*)(gp + (9 + 2 * ax) * 16 + 4);
      const ATT_GAS float* ct = (const ATT_GAS float*)ropetab + ((size_t)tpos * 2 + ax) * 16 + hi * 8;
      const f32x4_ c0 = *(const ATT_GAS f32x4_*)ct, c1 = *(const ATT_GAS f32x4_*)(ct + 4), s0 = *(const ATT_GAS f32x4_*)(ct + 2048 * 32), s1 = *(const ATT_GAS f32x4_*)(ct + 2048 * 32 + 4);
#pragma unroll
      for (int i = 0; i < 8; ++i) { const float g1_ = i < 4 ? ga0[i & 3] : ga1[i & 3], g2_ = i < 4 ? gb0[i & 3] : gb1[i & 3], c = i < 4 ? c0[i & 3] : c1[i & 3], s = i < 4 ? s0[i & 3] : s1[i & 3];
        const float y1 = x1[i] * rq * g1_, y2 = x2[i] * rq * g2_; x1[i] = lat ? (y1 * c - y2 * s) : y1; x2[i] = lat ? (y1 * s + y2 * c) : y2; }
      QPUT(8 + 2 * ax, x1); QPUT(9 + 2 * ax, x2); }
#undef QUNPK
#undef QPUT
  }
  const int sr = tid >> 4, sc = (tid & 15) * 8, vst0 = v_st(sr, sc), vst1 = v_st(32 + sr, sc);
  const int kr0 = tid / 24, kc0_ = (tid % 24) * 8, kr1 = (tid + 512) / 24, kc1_ = ((tid + 512) % 24) * 8, kr2 = (tid + 1024) / 24, kc2_ = ((tid + 1024) % 24) * 8;
  const int kst0 = KSWZ(kr0, kc0_ * 2), kst1 = KSWZ(kr1, kc1_ * 2), kst2 = KSWZ(kr2, kc2_ * 2);
  const int vb0 = (int)(uintptr_t)V_lds + v_rd_base(lane);
  const ATT_GAS bf16_t* Kh = (const ATT_GAS bf16_t*)(Kg + h * DQK); const ATT_GAS bf16_t* Vh = (const ATT_GAS bf16_t*)(Vg + h * DV);
  bf16x8 vs0, vs1, ks0, ks1, ks2;
#define KROW(t) ((t) < nctx_t ? kc0 + 64 * (t) : kl0 + 64 * ((t) - nctx_t))
#define SLOAD(t) do { const size_t k0_ = (size_t)KROW(t); \
    vs0 = *(const ATT_GAS bf16x8*)(&Vh[(k0_ + sr) * LDV + sc]); vs1 = *(const ATT_GAS bf16x8*)(&Vh[(k0_ + 32 + sr) * LDV + sc]); \
    ks0 = *(const ATT_GAS bf16x8*)(&Kh[(k0_ + kr0) * LDKK + kc0_]); ks1 = *(const ATT_GAS bf16x8*)(&Kh[(k0_ + kr1) * LDKK + kc1_]); \
    ks2 = *(const ATT_GAS bf16x8*)(&Kh[(k0_ + kr2) * LDKK + kc2_]); } while (0)
#define SWRITE(b) do { *(bf16x8*)(V_lds + (b) * SHM_V + vst0) = vs0; *(bf16x8*)(V_lds + (b) * SHM_V + vst1) = vs1; \
    *(bf16x8*)(K_lds + (b) * SHM_K + kst0) = ks0; *(bf16x8*)(K_lds + (b) * SHM_K + kst1) = ks1; *(bf16x8*)(K_lds + (b) * SHM_K + kst2) = ks2; } while (0)
#define SWAIT() asm volatile("s_waitcnt vmcnt(0)" ::: "memory")
#define RESC(a) do { if (__any((a) < 1.f)) { if (hi == 0) al_l[r32] = (a); asm volatile("s_waitcnt lgkmcnt(0)" ::: "memory"); \
    _Pragma("unroll") for (int d = 0; d < 4; ++d) _Pragma("unroll") for (int r = 0; r < 16; ++r) o[d][r] *= al_l[crow(r, hi)]; } } while (0)
  f32x16 pA0, pA1, pB0, pB1; float mnA, mnB, alA, alB; bf16x8 pa0, pa1, pa2, pa3;
  SLOAD(0); SWAIT(); SWRITE(0); __syncthreads();
  qkt(pA0, pA1, K_lds, qr, ql, r32, hi); partialSM(pA0, pA1, m_reg, mnA, alA);
  SLOAD(1);
  SWAIT(); SWRITE(1); __syncthreads();
  for (int j = 1; j + 1 < NT; j += 2) {
    SBAR(); qkt(pB0, pB1, K_lds + SHM_K, qr, ql, r32, hi);
    finishSM(pA0, pA1, alA, l_reg, pa0, pa1, pa2, pa3); SBAR();
    SLOAD(j + 1); SBAR();
    pv_d0(o, vb0, pa0, pa1, pa2, pa3); partialSM(pB0, pB1, m_reg, mnB, alB);
    __syncthreads(); SWAIT(); SWRITE(0);
    RESC(alB); __syncthreads();
    SBAR(); qkt(pA0, pA1, K_lds, qr, ql, r32, hi);
    finishSM(pB0, pB1, alB, l_reg, pa0, pa1, pa2, pa3); SBAR();
    SLOAD(j + 2); SBAR();
    pv_d0(o, vb0 + SHM_V, pa0, pa1, pa2, pa3); partialSM(pA0, pA1, m_reg, mnA, alA);
    __syncthreads(); SWAIT(); SWRITE(1);
    RESC(alA); __syncthreads();
  }
  SBAR(); qkt(pB0, pB1, K_lds + SHM_K, qr, ql, r32, hi);
  finishSM(pA0, pA1, alA, l_reg, pa0, pa1, pa2, pa3); SBAR();
  pv_d0(o, vb0, pa0, pa1, pa2, pa3); partialSM(pB0, pB1, m_reg, mnB, alB);
  __syncthreads(); RESC(alB);
  finishSM(pB0, pB1, alB, l_reg, pa0, pa1, pa2, pa3); SBAR();
  pv_d0(o, vb0 + SHM_V, pa0, pa1, pa2, pa3);
  if (hi == 0) li_l[r32] = l_reg; asm volatile("s_waitcnt lgkmcnt(0)" ::: "memory");
  float rli[16];
#pragma unroll
  for (int r = 0; r < 16; ++r) rli[r] = __builtin_amdgcn_rcpf(li_l[crow(r, hi)]);
  ATT_GAS bf16_t* Ow = (ATT_GAS bf16_t*)(Og + (size_t)(qrow0 + wid * QBLK) * LDO + h * DQK);
#pragma unroll
  for (int r = 0; r < 16; ++r) { const int orow = crow(r, hi);
#pragma unroll
    for (int d0 = 0; d0 < 4; ++d0) { const unsigned w = cvtpk(o[d0][r] * rli[r], 0.f); Ow[(size_t)orow * LDO + d0 * 32 + r32] = (bf16_t)(w & 0xffffu); } }
  __syncthreads();
#undef KROW
#undef SLOAD
#undef SWRITE
#undef SWAIT
#undef RESC
}
#undef KSWZ
#undef SBAR
}

#define LAS __attribute__((address_space(3)))
#define GAS __attribute__((address_space(1)))
typedef unsigned short bf16;
typedef float f32x4 __attribute__((ext_vector_type(4)));
typedef unsigned u32x4 __attribute__((ext_vector_type(4)));
typedef unsigned u32x2 __attribute__((ext_vector_type(2)));

constexpr int D = 1024, NBATCH = 16, SEQ = 2048, CTXL = 256, DEPTH = 4;
constexpr int RL = NBATCH * SEQ, RC = NBATCH * CTXL, RT = RL + RC;
constexpr int DFF = 2816, NCOND = 17, MODW = 9 * D;
constexpr float EPS = 1e-6f;
constexpr float QSC = 0.07216878364870322f * 1.4426950408889634f;
constexpr int NWAVES = 8;
constexpr int LDS_BYTES = 147456;

enum { I_X = 0, I_C, I_CTX, I_CCTX, I_WMOD, I_BMOD, I_GNORM, I_W1, I_W3, I_W2, I_SCWIN, I_SCCONV, I_SCWOUT, I_WA, I_GQA, I_WUQ, I_GKVA, I_WUKV, I_GQ, I_GK, I_WO, N_IN };

constexpr size_t MiB = 1u << 20;
constexpr size_t OFF_MOD = 0;
constexpr size_t OFF_ROPE = 4 * MiB;
constexpr size_t OFF_STAT = 4 * MiB + 512 * 1024;
constexpr size_t OFF_CTL = 6 * MiB, CTL_BYTES = 65536;

constexpr size_t OFF_WUP = 8 * MiB;
constexpr size_t SZ_WUP = (size_t)5632 * 1024 * 2;
constexpr size_t OFF_WDN = 96 * MiB;
constexpr size_t SZ_WDN = (size_t)1024 * 2816 * 2;
constexpr size_t OFF_WIN = 140 * MiB;
constexpr size_t SZ_WIN = (size_t)3072 * 1024 * 2;
constexpr size_t OFF_WOUT = 152 * MiB;
constexpr size_t SZ_SQ = (size_t)1024 * 1024 * 2;
constexpr size_t OFF_WA = 156 * MiB;
constexpr size_t SZ_WA = (size_t)512 * 1024 * 2;
constexpr size_t OFF_WUQ = 158 * MiB;
constexpr size_t SZ_WUQ = (size_t)1536 * 256 * 2;
constexpr size_t OFF_WUKV = 160 * MiB;
constexpr size_t SZ_WUKV = (size_t)2048 * 128 * 2;
constexpr size_t OFF_WO = 160 * MiB + 2 * MiB;
constexpr size_t SZ_WO = (size_t)1024 * 1536 * 2;
constexpr size_t OFF_HCTX = 168 * MiB;
constexpr size_t OFF_NH = 184 * MiB;
constexpr size_t OFF_BIG = 256 * MiB;
constexpr size_t OFF_ACT = OFF_BIG;
constexpr size_t OFF_BB = OFF_BIG;
constexpr size_t OFF_VV = OFF_BIG + 72 * MiB;
constexpr size_t OFF_YY = OFF_BIG + 144 * MiB;
constexpr size_t OFF_CQKV = OFF_BIG;
constexpr size_t OFF_Q = OFF_BIG + 36 * MiB;
constexpr size_t OFF_K = OFF_BIG + 144 * MiB;
constexpr size_t OFF_V = OFF_BIG + 252 * MiB;
constexpr size_t OFF_BIAS = OFF_BIG + 324 * MiB;
constexpr size_t BIAS_UP = 0, BIAS_WIN = (size_t)8 * 17 * 5632, BIAS_WA = BIAS_WIN + (size_t)2 * 17 * 3072;
constexpr size_t OFF_SS = OFF_BIAS + 4 * MiB;
constexpr size_t WS_END = OFF_BIAS + 8 * MiB;

struct Params { const float* in[N_IN]; float* out; unsigned char* ws; int pad0, pad1; };
constexpr int MISC_OFF = LDS_BYTES - 512;
constexpr int PTAB_OFF = LDS_BYTES - 256, I_OUT = N_IN, I_WS = N_IN + 1;
__device__ __forceinline__ unsigned long long ldp_raw(int i) {
    volatile LAS unsigned* t = (volatile LAS unsigned*)(uintptr_t)PTAB_OFF;
    const unsigned lo = __builtin_amdgcn_readfirstlane(t[2 * i]), hi = __builtin_amdgcn_readfirstlane(t[2 * i + 1]);
    return ((unsigned long long)hi << 32) | lo;
}
__device__ __forceinline__ const float* ldp(int i) { return (const float*)ldp_raw(i); }
__device__ __forceinline__ unsigned char* ldws() { return (unsigned char*)ldp_raw(I_WS); }

__device__ __forceinline__ float wave_sum(float v) {
#pragma unroll
    for (int o = 1; o < 64; o <<= 1) v += __shfl_xor(v, o);
    return v;
}
__device__ __forceinline__ float wave_sum_dpp(float v) {
    v += __builtin_bit_cast(float, __builtin_amdgcn_mov_dpp(__builtin_bit_cast(int, v), 0xB1, 0xf, 0xf, false));
    v += __builtin_bit_cast(float, __builtin_amdgcn_mov_dpp(__builtin_bit_cast(int, v), 0x4E, 0xf, 0xf, false));
    v += __builtin_bit_cast(float, __builtin_amdgcn_mov_dpp(__builtin_bit_cast(int, v), 0x141, 0xf, 0xf, false));
    v += __builtin_bit_cast(float, __builtin_amdgcn_mov_dpp(__builtin_bit_cast(int, v), 0x140, 0xf, 0xf, false));
    return pg8::xrow_sum(v);
}
__device__ __forceinline__ unsigned f2bf(float f) { unsigned u = __builtin_bit_cast(unsigned, f); return (u + 0x7fffu + ((u >> 16) & 1u)) >> 16; }
__device__ __forceinline__ unsigned pk2(float lo, float hi) { unsigned r; asm("v_cvt_pk_bf16_f32 %0, %1, %2" : "=v"(r) : "v"(lo), "v"(hi)); return r; }
__device__ __forceinline__ float bf_lo(unsigned w) { return __builtin_bit_cast(float, w << 16); }
__device__ __forceinline__ float bf_hi(unsigned w) { return __builtin_bit_cast(float, w & 0xffff0000u); }

__device__ __forceinline__ void transpose_item(const float* W, int K, int N, bf16* WT, int Kd, int mode, const float* kscale, LAS float* scr, int item, int lane) {
    const int nblk = N / 32, kb = item / nblk, nb = item % nblk, k0 = 64 * kb, n0 = 32 * nb;
    float tv[32];
#pragma unroll
    for (int i = 0; i < 32; ++i) { const int kk = 2 * i + (lane >> 5); tv[i] = W[(size_t)(k0 + kk) * N + n0 + (lane & 31)]; }
#pragma unroll
    for (int i = 0; i < 32; ++i) { const int kk = 2 * i + (lane >> 5); scr[kk * 33 + (lane & 31)] = tv[i]; }
    asm volatile("s_waitcnt lgkmcnt(0)" ::: "memory");
    int r0;
    if (mode == 0) r0 = n0;
    else if (mode == 1) r0 = 256 * (n0 >> 7) + (n0 & 127);
    else if (mode == 2) r0 = 256 * (n0 >> 7) + 128 + (n0 & 127);
    else { if (n0 < 1024) r0 = n0; else if (n0 < 2048) { const int c = n0 - 1024; r0 = 1024 + 256 * (c >> 7) + (c & 127); } else { const int c = n0 - 2048; r0 = 1024 + 256 * (c >> 7) + 128 + (c & 127); } }
    const int c = lane & 7; const int kd0 = (mode == 4) ? 192 * (k0 >> 7) + (k0 & 127) : k0;
    float ks[8];
#pragma unroll
    for (int q = 0; q < 8; ++q) ks[q] = kscale ? kscale[k0 + 8 * c + q] : 1.0f;
#pragma unroll
    for (int j = 0; j < 4; ++j) { const int n = (lane >> 3) + 8 * j; const LAS float* s = scr + (8 * c) * 33 + n;
        u32x4 o; o.x = pk2(s[0 * 33] * ks[0], s[1 * 33] * ks[1]); o.y = pk2(s[2 * 33] * ks[2], s[3 * 33] * ks[3]); o.z = pk2(s[4 * 33] * ks[4], s[5 * 33] * ks[5]); o.w = pk2(s[6 * 33] * ks[6], s[7 * 33] * ks[7]);
        *(u32x4*)(WT + (size_t)(r0 + n) * Kd + kd0 + 8 * c) = o; }
    asm volatile("s_waitcnt lgkmcnt(0)" ::: "memory");
}

constexpr int IT_FFN = 1408;
constexpr int IT_A0 = 0, IT_B0 = IT_A0 + 8 * IT_FFN, IT_C0 = IT_B0 + 8 * IT_FFN, IT_D0 = IT_C0 + 8 * IT_FFN;
constexpr int IT_WIN = 16 * 96, IT_SQ = 16 * 32, IT_WA = 16 * 14, IT_WUQ = 4 * 48, IT_WUKV = 2 * 64;
constexpr int IT_E0 = IT_D0 + 2 * IT_WIN, IT_F0 = IT_E0 + 2 * IT_SQ, IT_G0 = IT_F0 + 2 * IT_SQ, IT_H0 = IT_G0 + 2 * IT_WA, IT_I0 = IT_H0 + 2 * IT_WUQ, IT_END = IT_I0 + 2 * IT_WUKV;

__device__ __forceinline__ void convert_item(int it, LAS float* scr, int lane) {
    unsigned char* ws = ldws();
    if (it < IT_B0) { const int m = it / IT_FFN, r = it % IT_FFN; transpose_item(ldp(I_W1) + (size_t)m * D * DFF, D, DFF, (bf16*)(ws + OFF_WUP + m * SZ_WUP), D, 1, nullptr, scr, r, lane); return; }
    if (it < IT_C0) { it -= IT_B0; const int m = it / IT_FFN, r = it % IT_FFN; transpose_item(ldp(I_W3) + (size_t)m * D * DFF, D, DFF, (bf16*)(ws + OFF_WUP + m * SZ_WUP), D, 2, nullptr, scr, r, lane); return; }
    if (it < IT_D0) { it -= IT_C0; const int m = it / IT_FFN, r = it % IT_FFN; transpose_item(ldp(I_W2) + (size_t)m * DFF * D, DFF, D, (bf16*)(ws + OFF_WDN + m * SZ_WDN), DFF, 0, nullptr, scr, r, lane); return; }
    if (it < IT_E0) { it -= IT_D0; const int m = it / IT_WIN, r = it % IT_WIN; transpose_item(ldp(I_SCWIN) + (size_t)m * D * 3072, D, 3072, (bf16*)(ws + OFF_WIN + m * SZ_WIN), D, 3, nullptr, scr, r, lane); return; }
    if (it < IT_F0) { it -= IT_E0; const int m = it / IT_SQ, r = it % IT_SQ; transpose_item(ldp(I_SCWOUT) + (size_t)m * D * D, D, D, (bf16*)(ws + OFF_WOUT + m * SZ_SQ), D, 0, nullptr, scr, r, lane); return; }
    if (it < IT_G0) { it -= IT_F0; const int m = it / IT_SQ, r = it % IT_SQ; transpose_item(ldp(I_WO) + (size_t)m * D * D, D, D, (bf16*)(ws + OFF_WO + m * SZ_WO), 1536, 4, nullptr, scr, r, lane); return; }
    if (it < IT_H0) { it -= IT_G0; const int m = it / IT_WA, r = it % IT_WA; transpose_item(ldp(I_WA) + (size_t)m * D * 448, D, 448, (bf16*)(ws + OFF_WA + m * SZ_WA), D, 0, nullptr, scr, r, lane); return; }
    if (it < IT_I0) { it -= IT_H0; const int m = it / IT_WUQ, r = it % IT_WUQ; transpose_item(ldp(I_WUQ) + (size_t)m * 256 * 1536, 256, 1536, (bf16*)(ws + OFF_WUQ + m * SZ_WUQ), 256, 0, ldp(I_GQA) + m * 256, scr, r, lane); return; }
    { it -= IT_I0; const int m = it / IT_WUKV, r = it % IT_WUKV; transpose_item(ldp(I_WUKV) + (size_t)m * 128 * 2048, 128, 2048, (bf16*)(ws + OFF_WUKV + m * SZ_WUKV), 128, 0, ldp(I_GKVA) + m * 128, scr, r, lane); }
}

__device__ __forceinline__ void mod_group(int grp, LAS unsigned char* lds, int tid, int wave, int lane) {
    LAS float* S = (LAS float*)lds;
    const float* cin = ldp(I_C); const float* cctx = ldp(I_CCTX);
    for (int i = tid; i < NCOND * 1024; i += 512) { const int c = i >> 10, k = i & 1023; const float v = c < 16 ? cin[c * 1024 + k] : cctx[k]; S[i] = v / (1.0f + __expf(-v)); }
    __syncthreads();
    const int l = grp / 36, cg0 = (grp % 36) * 256;
    const float* W = ldp(I_WMOD) + (size_t)l * 1024 * MODW + cg0 + lane * 4;
    const int kbase = wave * 128;
    f32x4 acc[NCOND];
#pragma unroll
    for (int c = 0; c < NCOND; ++c) acc[c] = (f32x4){0.f, 0.f, 0.f, 0.f};
    for (int kk = 0; kk < 128; kk += 4) {
        const float* wp = W + (size_t)(kbase + kk) * MODW;
        const f32x4 w0 = *(const f32x4*)(wp), w1 = *(const f32x4*)(wp + MODW), w2 = *(const f32x4*)(wp + 2 * MODW), w3 = *(const f32x4*)(wp + 3 * MODW);
#pragma unroll
        for (int c = 0; c < NCOND; ++c) { const f32x4 s = *(const LAS f32x4*)(S + c * 1024 + kbase + kk); acc[c] += w0 * s.x + w1 * s.y + w2 * s.z + w3 * s.w; }
    }
    __syncthreads();
    LAS float* P = (LAS float*)lds;
#pragma unroll
    for (int c = 0; c < NCOND; ++c) *(LAS f32x4*)(P + (wave * NCOND + c) * 256 + lane * 4) = acc[c];
    __syncthreads();
    float* MOD = (float*)(ldws() + OFF_MOD); const float* bmod = ldp(I_BMOD);
    for (int o = tid; o < NCOND * 256; o += 512) { const int c = o >> 8, col = o & 255; float s = bmod[l * MODW + cg0 + col];
#pragma unroll
        for (int w = 0; w < 8; ++w) s += P[(w * NCOND + c) * 256 + col];
        MOD[(size_t)(l * NCOND + c) * MODW + cg0 + col] = s; }
    __syncthreads();
}

__device__ __forceinline__ void norm_phase(const float* hl, const float* hc, const float* g, const float* modl, int chunk, bf16* NH, int nrows, int gw, int NGW, int lane) {
    for (int row = gw; row < nrows; row += NGW) {
        const float* src = row < RL ? hl + (size_t)row * D : hc + (size_t)(row - RL) * D;
        const int cond = row < RL ? (row >> 11) : 16;
        const float* sh = modl + (size_t)cond * MODW + chunk * D; const float* sc = sh + D;
        f32x4 v[4]; float s = 0.f;
#pragma unroll
        for (int j = 0; j < 4; ++j) { v[j] = ((const f32x4*)src)[lane + 64 * j]; s += (v[j].x * v[j].x + v[j].y * v[j].y) + (v[j].z * v[j].z + v[j].w * v[j].w); }
        const float rstd = rsqrtf(wave_sum(s) * (1.0f / D) + EPS);
        u32x2* o8 = (u32x2*)(NH + (size_t)row * D) + lane;
#pragma unroll
        for (int j = 0; j < 4; ++j) { const f32x4 gg = ((const f32x4*)g)[lane + 64 * j], ss = ((const f32x4*)sc)[lane + 64 * j], hh = ((const f32x4*)sh)[lane + 64 * j];
            const f32x4 y = v[j] * rstd * gg * (ss + 1.0f) + hh; u32x2 w; w.x = pk2(y.x, y.y); w.y = pk2(y.z, y.w); o8[64 * j] = w; }
    }
}


__device__ __forceinline__ void bias_unit(int unit, LAS unsigned char* lds, int tid, int wave, int lane) {
    unsigned char* ws = ldws(); const float* MOD = (const float*)(ws + OFF_MOD); float* BIAS = (float*)(ws + OFF_BIAS);
    int l, chunk, N, row0; const bf16* Bt; float* out;
    if (unit < 352) { const int m = unit / 44; l = m >> 1; chunk = (m & 1) ? 6 : 0; N = 5632; row0 = (unit % 44) * 128; Bt = (const bf16*)(ws + OFF_WUP + m * SZ_WUP); out = BIAS + BIAS_UP + (size_t)m * 17 * 5632; }
    else if (unit < 400) { const int j = (unit - 352) / 24; l = 2 * j; chunk = 3; N = 3072; row0 = ((unit - 352) % 24) * 128; Bt = (const bf16*)(ws + OFF_WIN + j * SZ_WIN); out = BIAS + BIAS_WIN + (size_t)j * 17 * 3072; }
    else { const int j = (unit - 400) / 4; l = 2 * j + 1; chunk = 3; N = 512; row0 = ((unit - 400) % 4) * 128; Bt = (const bf16*)(ws + OFF_WA + j * SZ_WA); out = BIAS + BIAS_WA + (size_t)j * 17 * 512; }
    LAS float* S = (LAS float*)lds;
    __syncthreads();
    for (int i = tid; i < NCOND * 1024; i += 512) { const int c = i >> 10, k = i & 1023; S[i] = MOD[(size_t)(l * NCOND + c) * MODW + chunk * D + k]; }
    __syncthreads();
    for (int r = 0; r < 16; ++r) { const int n = row0 + wave * 16 + r;
        float w[16];
#pragma unroll
        for (int q = 0; q < 4; ++q) { const u32x2 v = *(const u32x2*)(Bt + (size_t)n * D + 256 * q + 4 * lane); w[4 * q] = bf_lo(v.x); w[4 * q + 1] = bf_hi(v.x); w[4 * q + 2] = bf_lo(v.y); w[4 * q + 3] = bf_hi(v.y); }
        float mine = 0.f;
#pragma unroll
        for (int c = 0; c < NCOND; ++c) { float a = 0.f;
#pragma unroll
            for (int q = 0; q < 4; ++q) { const f32x4 sv = *(const LAS f32x4*)(S + c * 1024 + 256 * q + 4 * lane); a += sv.x * w[4 * q] + sv.y * w[4 * q + 1] + sv.z * w[4 * q + 2] + sv.w * w[4 * q + 3]; }
            a = wave_sum_dpp(a); mine = (lane == c) ? a : mine; }
        if (lane < NCOND) out[(size_t)lane * N + n] = mine;
    }
}
__device__ __forceinline__ void first_aprime(const float* xl, const float* xc, const float* g, const float* sc0, bf16* NH, float* SS, int gw, int NGW, int lane) {
    for (int row0 = gw; row0 < RT; row0 += 2 * NGW) {
        f32x4 v[2][4];
#pragma unroll
        for (int q = 0; q < 2; ++q) { const int row = (row0 + q * NGW < RT) ? row0 + q * NGW : row0; const float* src = row < RL ? xl + (size_t)row * D : xc + (size_t)(row - RL) * D;
#pragma unroll
            for (int j = 0; j < 4; ++j) v[q][j] = ((const f32x4*)src)[lane + 64 * j]; }
#pragma unroll
        for (int q = 0; q < 2; ++q) { const int row = row0 + q * NGW; if (row < RT) {
            const int cond = row < RL ? (row >> 11) : 16; const float* sc = sc0 + (size_t)cond * MODW; float s = 0.f;
#pragma unroll
            for (int j = 0; j < 4; ++j) s += (v[q][j].x * v[q][j].x + v[q][j].y * v[q][j].y) + (v[q][j].z * v[q][j].z + v[q][j].w * v[q][j].w);
            s = wave_sum_dpp(s); if (lane < 16) SS[(size_t)row * 16 + lane] = (lane == 0) ? s : 0.f;
            u32x2* o8 = (u32x2*)(NH + (size_t)row * D) + lane;
#pragma unroll
            for (int j = 0; j < 4; ++j) { const f32x4 gg = ((const f32x4*)g)[lane + 64 * j], ss = ((const f32x4*)sc)[lane + 64 * j];
                const f32x4 y = v[q][j] * gg * (ss + 1.0f); u32x2 w; w.x = pk2(y.x, y.y); w.y = pk2(y.z, y.w); o8[64 * j] = w; } } }
    }
}


__device__ __forceinline__ void ctx_fix(const float* hin, float* hout, const float* part, const float* gate16, float gs, bf16* NHc, float* SSc_, const float* gn, const float* sc16, int gw, int NGW, int lane) {
    for (int r = gw; r < RC; r += NGW) {
        const GAS f32x4* hp = (const GAS f32x4*)(hin + (size_t)r * D) + lane; GAS f32x4* op = (GAS f32x4*)(hout + (size_t)r * D) + lane;
        f32x4 h[4], p[4][4];
#pragma unroll
        for (int j = 0; j < 4; ++j) { h[j] = hp[64 * j];
#pragma unroll
            for (int q = 0; q < 4; ++q) { const u32x2 w_ = ((const GAS u32x2*)((const bf16*)part + ((size_t)q * RC + r) * D) + lane)[64 * j]; p[q][j] = (f32x4){bf_lo(w_.x), bf_hi(w_.x), bf_lo(w_.y), bf_hi(w_.y)}; } }
        float sq = 0.f; f32x4 o[4];
#pragma unroll
        for (int j = 0; j < 4; ++j) { const f32x4 gg = ((const f32x4*)gate16)[lane + 64 * j] * gs; o[j] = h[j] + gg * (((p[0][j] + p[1][j]) + p[2][j]) + p[3][j]); op[64 * j] = o[j];
            sq += (o[j].x * o[j].x + o[j].y * o[j].y) + (o[j].z * o[j].z + o[j].w * o[j].w); }
        if (gn) {
            sq = wave_sum_dpp(sq); if (lane < 16) SSc_[(size_t)(RL + r) * 16 + lane] = (lane == 0) ? sq : 0.f;
            GAS u32x2* a8 = (GAS u32x2*)(NHc + (size_t)(RL + r) * D) + lane;
#pragma unroll
            for (int j = 0; j < 4; ++j) { const f32x4 y = o[j] * ((const f32x4*)gn)[lane + 64 * j] * (((const f32x4*)sc16)[lane + 64 * j] + 1.0f); u32x2 w; w.x = pk2(y.x, y.y); w.y = pk2(y.z, y.w); a8[64 * j] = w; }
        }
    }
}

__device__ __forceinline__ void stats_phase(const bf16* CQKV, float* rq, float* rkv, int gw, int NGW, int lane) {
    for (int row = gw; row < RT; row += NGW) {
        const u32x2 a = *((const u32x2*)(CQKV + (size_t)row * 512) + lane);
        float sq = bf_lo(a.x) * bf_lo(a.x) + bf_hi(a.x) * bf_hi(a.x) + bf_lo(a.y) * bf_lo(a.y) + bf_hi(a.y) * bf_hi(a.y);
        float sk = 0.f;
        if (lane < 32) { const u32x2 b = *((const u32x2*)(CQKV + (size_t)row * 512 + 256) + lane); sk = bf_lo(b.x) * bf_lo(b.x) + bf_hi(b.x) * bf_hi(b.x) + bf_lo(b.y) * bf_lo(b.y) + bf_hi(b.y) * bf_hi(b.y); }
        sq = wave_sum_dpp(sq); sk = wave_sum(sk);
        if (lane == 0) { rq[row] = rsqrtf(sq * (1.0f / 256.0f) + EPS); rkv[row] = rsqrtf(sk * (1.0f / 128.0f) + EPS); }
    }
}

__device__ __forceinline__ void unpack8(const u32x4 w, float* x) { x[0] = bf_lo(w.x); x[1] = bf_hi(w.x); x[2] = bf_lo(w.y); x[3] = bf_hi(w.y); x[4] = bf_lo(w.z); x[5] = bf_hi(w.z); x[6] = bf_lo(w.w); x[7] = bf_hi(w.w); }
__device__ __forceinline__ float dpp_xor1(float v) { return __builtin_bit_cast(float, __builtin_amdgcn_mov_dpp(__builtin_bit_cast(int, v), 0xB1, 0xf, 0xf, false)); }
__device__ __forceinline__ float dpp_xor2(float v) { return __builtin_bit_cast(float, __builtin_amdgcn_mov_dpp(__builtin_bit_cast(int, v), 0x4E, 0xf, 0xf, false)); }
__device__ __forceinline__ float dpp_hmirror(float v) { return __builtin_bit_cast(float, __builtin_amdgcn_mov_dpp(__builtin_bit_cast(int, v), 0x141, 0xf, 0xf, false)); }
__device__ __forceinline__ void qk_fin8(const u32x4 (&w)[3], const float (&g)[3][8], const float* cs, const float* sn, bool rope, bool second, float outscale, u32x4 (&o)[3]) {
    float x[3][8]; float ss = 0.f;
#pragma unroll
    for (int j = 0; j < 3; ++j) { unpack8(w[j], x[j]);
#pragma unroll
        for (int i = 0; i < 8; ++i) ss += x[j][i] * x[j][i]; }
    ss += dpp_xor1(ss); ss += dpp_xor2(ss); ss += dpp_hmirror(ss);
    const float r = rsqrtf(ss * (1.0f / 192.0f) + EPS);
#pragma unroll
    for (int j = 0; j < 3; ++j)
#pragma unroll
        for (int i = 0; i < 8; ++i) x[j][i] = x[j][i] * r * g[j][i];
    float pr[8];
#pragma unroll
    for (int i = 0; i < 8; ++i) pr[i] = dpp_xor2(x[2][i]);
    if (rope) {
#pragma unroll
        for (int i = 0; i < 8; ++i) x[2][i] = second ? (pr[i] * sn[i] + x[2][i] * cs[i]) : (x[2][i] * cs[i] - pr[i] * sn[i]);
    }
#pragma unroll
    for (int j = 0; j < 3; ++j) { o[j].x = pk2(x[j][0] * outscale, x[j][1] * outscale); o[j].y = pk2(x[j][2] * outscale, x[j][3] * outscale); o[j].z = pk2(x[j][4] * outscale, x[j][5] * outscale); o[j].w = pk2(x[j][6] * outscale, x[j][7] * outscale); }
}
__device__ __forceinline__ void finalize_phase(bf16* Qb_, bf16* Kb_, const bf16* CQKV_, const float* gq, const float* gk, const float* ropetab, bool need_qc, int gw, int NGW, int lane) {
    GAS bf16* Kb = (GAS bf16*)Kb_; const GAS bf16* CQKV = (const GAS bf16*)CQKV_; const GAS float* rt = (const GAS float*)ropetab;
    const int l8 = lane & 7, head = lane >> 3;
    float gkv[3][8];
#pragma unroll
    for (int j = 0; j < 3; ++j)
#pragma unroll
        for (int i = 0; i < 8; ++i) gkv[j][i] = gk[(l8 + 8 * j) * 8 + i];
    const int axis = (l8 >= 4) ? 1 : 0, f0 = 8 * (l8 & 1); const bool second = (l8 & 2) != 0;
    for (int row0 = gw; row0 < RT; row0 += 4 * NGW) {
        u32x4 kw[4][3]; f32x4 cc[4][4];
#pragma unroll
        for (int q = 0; q < 4; ++q) { const int row = (row0 + q * NGW < RT) ? row0 + q * NGW : row0; const int t = row < RL ? (row & (SEQ - 1)) : 0;
            const GAS float* ct = rt + ((size_t)t * 2 + axis) * 16 + f0; const size_t o0 = (size_t)row * 1536 + head * 192 + l8 * 8;
            cc[q][0] = *(const GAS f32x4*)ct; cc[q][1] = *(const GAS f32x4*)(ct + 4); cc[q][2] = *(const GAS f32x4*)(ct + SEQ * 32); cc[q][3] = *(const GAS f32x4*)(ct + SEQ * 32 + 4);
            kw[q][0] = *(const GAS u32x4*)(Kb + o0); kw[q][1] = *(const GAS u32x4*)(Kb + o0 + 64); kw[q][2] = *(const GAS u32x4*)(CQKV + (size_t)row * 512 + 384 + l8 * 8); }
#pragma unroll
        for (int q = 0; q < 4; ++q) { const int row = row0 + q * NGW; if (row < RT) {
            const float cs[8] = {cc[q][0].x, cc[q][0].y, cc[q][0].z, cc[q][0].w, cc[q][1].x, cc[q][1].y, cc[q][1].z, cc[q][1].w}, sn[8] = {cc[q][2].x, cc[q][2].y, cc[q][2].z, cc[q][2].w, cc[q][3].x, cc[q][3].y, cc[q][3].z, cc[q][3].w};
            u32x4 ov[3]; qk_fin8(kw[q], gkv, cs, sn, row < RL, second, 1.0f, ov);
            const size_t o0 = (size_t)row * 1536 + head * 192 + l8 * 8;
#pragma unroll
            for (int j = 0; j < 3; ++j) *(GAS u32x4*)(Kb + o0 + 64 * j) = ov[j]; } }
    }
}

__device__ __forceinline__ void conv_phase(const bf16* Bb_, const bf16* Vb_, const float* cw, bf16* Y_, int gtid, int NT_) {
    const GAS bf16* Bb = (const GAS bf16*)Bb_; const GAS bf16* Vb = (const GAS bf16*)Vb_; GAS bf16* Y = (GAS bf16*)Y_;
    const int c8 = (gtid & 127) * 8;
    float w0[8], w1[8], w2[8];
#pragma unroll
    for (int i = 0; i < 8; ++i) { w0[i] = cw[c8 + i]; w1[i] = cw[D + c8 + i]; w2[i] = cw[2 * D + c8 + i]; }
    for (int it0 = gtid; it0 < RT * 128; it0 += 4 * NT_) {
        u32x4 lb[4], l0[4], l1[4], l2[4]; float m0[4], m2[4];
#pragma unroll
        for (int q = 0; q < 4; ++q) { const int it = (it0 + q * NT_ < RT * 128) ? it0 + q * NT_ : it0;
            const int row = it >> 7;
            const int pos = row < RL ? (row & (SEQ - 1)) : ((row - RL) & (CTXL - 1)); const int len = row < RL ? SEQ : CTXL;
            const size_t off = (size_t)row * D + c8; const bool hp = pos > 0, hn = pos < len - 1;
            lb[q] = *(const GAS u32x4*)(Bb + off); l1[q] = *(const GAS u32x4*)(Vb + off);
            l0[q] = *(const GAS u32x4*)(Vb + (hp ? off - D : off)); l2[q] = *(const GAS u32x4*)(Vb + (hn ? off + D : off));
            m0[q] = hp ? 1.f : 0.f; m2[q] = hn ? 1.f : 0.f; }
#pragma unroll
        for (int q = 0; q < 4; ++q) { const int it = it0 + q * NT_; if (it < RT * 128) {
            const int row = it >> 7; const size_t off = (size_t)row * D + c8;
            float b[8], v0[8], v1[8], v2[8], y[8];
            unpack8(lb[q], b); unpack8(l0[q], v0); unpack8(l1[q], v1); unpack8(l2[q], v2);
#pragma unroll
            for (int i = 0; i < 8; ++i) y[i] = b[i] * (w0[i] * m0[q] * v0[i] + w1[i] * v1[i] + w2[i] * m2[q] * v2[i]);
            u32x4 o; o.x = pk2(y[0], y[1]); o.y = pk2(y[2], y[3]); o.z = pk2(y[4], y[5]); o.w = pk2(y[6], y[7]);
            *(GAS u32x4*)(Y + off) = o; } }
    }
}

#define XB_TMO      128
#define XB_XCNT(j)  (256  + 64 * (j))
#define XB_XSUB(j)  (1280 + 64 * (j))
#define XB_XGEN(j)  (2304 + 64 * (j))
#define XB_TOP      3328
#define XB_TOPGEN   3392
#define XCD_BAR_WORDS 3456
#define XB_SPIN_CAP (1u << 18)

__device__ __forceinline__ unsigned xb_ld(unsigned* p)              { return __hip_atomic_load(p, __ATOMIC_RELAXED, __HIP_MEMORY_SCOPE_AGENT); }
__device__ __forceinline__ unsigned xb_add(unsigned* p, unsigned v) { return __hip_atomic_fetch_add(p, v, __ATOMIC_RELAXED, __HIP_MEMORY_SCOPE_AGENT); }
__device__ __forceinline__ unsigned xb_xcc_id() { return (unsigned)__builtin_amdgcn_s_getreg((3 << 11) | 20) & 0xFu; }
#define XB_SPIN(cond, bar) do { unsigned _sp = 0; while (cond) { __builtin_amdgcn_s_sleep(1); \
    if ((++_sp & 255u) == 0u) { if (xb_ld(&(bar)[XB_TMO])) break; if (_sp > XB_SPIN_CAP) { atomicAdd(&(bar)[XB_TMO], 1u); break; } } } } while (0)

struct XcdBarrier {
    unsigned* bar; unsigned x;
    volatile LAS unsigned* st;
};

__device__ __forceinline__ XcdBarrier xcd_barrier_post(unsigned* bar, volatile LAS unsigned* st) {
    XcdBarrier b; b.bar = bar; b.x = xb_xcc_id(); b.st = st;
    if (threadIdx.x == 0) (void)xb_add(&bar[XB_XCNT(b.x)], 1u);
    return b;
}
__device__ __forceinline__ void xcd_barrier_complete(unsigned* bar, unsigned x, unsigned& nloc, unsigned& nx) {
    const unsigned G = gridDim.x * gridDim.y * gridDim.z;
    unsigned sum, cnt, mine, sp = 0u;
    for (;;) {
        sum = 0u; cnt = 0u; mine = 0u;
#pragma unroll
        for (unsigned j = 0; j < 16; ++j) { const unsigned c = xb_ld(&bar[XB_XCNT(j)]); sum += c; cnt += (c > 0u) ? 1u : 0u; mine = (j == x) ? c : mine; }
        if (sum == G) break;
        __builtin_amdgcn_s_sleep(1);
        if ((++sp & 255u) == 0u) { if (xb_ld(&bar[XB_TMO])) break; if (sp > XB_SPIN_CAP) { atomicAdd(&bar[XB_TMO], 1u); break; } }
    }
    nloc = mine > 0u ? mine : 1u; nx = cnt > 0u ? cnt : 1u;
}

__device__ __forceinline__ void xcd_barrier(const XcdBarrier& b) {
    asm volatile("s_waitcnt vmcnt(0)" ::: "memory");
    __syncthreads();
    if (threadIdx.x == 0) {
        unsigned* bar = b.bar;
        __builtin_amdgcn_s_waitcnt(0);
        unsigned nloc = b.st[0], nx = b.st[1];
        if (nloc == 0u) { xcd_barrier_complete(bar, b.x, nloc, nx); b.st[0] = nloc; b.st[1] = nx; }
        const unsigned old = xb_add(&bar[XB_XSUB(b.x)], 1u);
        const unsigned gen = old / nloc;
        if (old + 1u == (gen + 1u) * nloc) {
            __builtin_amdgcn_fence(__ATOMIC_RELEASE, "agent");
            asm volatile("s_waitcnt vmcnt(0)" ::: "memory");
            const unsigned og = xb_add(&bar[XB_TOP], 1u);
            const unsigned tg = og / nx;
            if (og + 1u == (tg + 1u) * nx) xb_add(&bar[XB_TOPGEN], 1u);
            else XB_SPIN(xb_ld(&bar[XB_TOPGEN]) == tg, bar);
            __builtin_amdgcn_fence(__ATOMIC_ACQUIRE, "agent");
            xb_add(&bar[XB_XGEN(b.x)], 1u);
            asm volatile("s_waitcnt vmcnt(0)" ::: "memory");
        } else {
            XB_SPIN(xb_ld(&bar[XB_XGEN(b.x)]) == gen, bar);
            __builtin_amdgcn_fence(__ATOMIC_ACQUIRE, "agent");
            asm volatile("s_waitcnt vmcnt(0)" ::: "memory");
        }
    }
    __syncthreads();
}


typedef pg8::GemmT<D, DFF, DFF> GemmDn; typedef pg8::GemmT<D, D, D> GemmSq; typedef pg8::GemmT<D, 1536, 1536> GemmWo;
#define GSYNC() do { XcdBarrier b_; b_.bar = (unsigned*)(ldws() + OFF_CTL); b_.x = xb_xcc_id(); b_.st = (volatile LAS unsigned*)(uintptr_t)MISC_OFF; xcd_barrier(b_); } while (0)
__global__ void __launch_bounds__(NWAVES * 64) fwd_megakernel(Params p) {
    extern __shared__ __attribute__((aligned(16))) unsigned char lds_raw[];
    cg::grid_group grid = cg::this_grid();
    LAS unsigned char* lds = (LAS unsigned char*)lds_raw;
    const int tid = threadIdx.x, lane = tid & 63, wave = __builtin_amdgcn_readfirstlane(tid >> 6);
    if (tid == 0) {
        volatile LAS unsigned long long* t = (volatile LAS unsigned long long*)(uintptr_t)PTAB_OFF;
#pragma unroll
        for (int i = 0; i < N_IN; ++i) t[i] = (unsigned long long)p.in[i];
        t[I_OUT] = (unsigned long long)p.out; t[I_WS] = (unsigned long long)p.ws;
        volatile LAS unsigned* m = (volatile LAS unsigned*)(uintptr_t)MISC_OFF; m[0] = 0u; m[1] = 0u;
    }
    __syncthreads();
    (void)xcd_barrier_post((unsigned*)(p.ws + OFF_CTL), (volatile LAS unsigned*)(uintptr_t)MISC_OFF);
    if (p.pad0 != 0) grid.sync();
#define BX() ({ int b_ = blockIdx.x; asm volatile("" : "+s"(b_)); b_; })
#define GD() ({ int g_ = gridDim.x; asm volatile("" : "+s"(g_)); g_; })
#define GW (BX() * NWAVES + wave)
#define NGW_ (GD() * NWAVES)

    {
        const int G = GD(), bx = BX();
#ifndef NO_MOD
        for (int g = bx; g < 144; g += G) mod_group(g, lds, tid, wave, lane);
#endif
        unsigned char* ws = ldws(); float* ROPE = (float*)(ws + OFF_ROPE);
        for (int i = bx * 512 + tid; i < SEQ * 32; i += G * 512) { const int t = i >> 5, axis = (i >> 4) & 1, f = i & 15; const float pos = (float)(axis ? (t & 63) : (t >> 6));
            const float inv = exp2f(-(float)f * (13.287712379549449f / 16.0f)); const float a = pos * inv; ROPE[i] = cosf(a); ROPE[SEQ * 32 + i] = sinf(a); }
        for (int i = bx * 512 + tid; i < 2 * 64 * 128; i += G * 512) { const int j = i / (64 * 128), r = (i / 128) % 64, c = i % 128; *(u32x4*)((bf16*)(ws + OFF_WA + j * SZ_WA) + (size_t)(448 + r) * 1024 + c * 8) = (u32x4){0u, 0u, 0u, 0u}; }
        for (int i = bx * 512 + tid; i < 2 * 1024 * 64; i += G * 512) { const int j = i >> 16, r = (i >> 6) & 1023, h = (i >> 3) & 7, c = i & 7; *(u32x4*)((bf16*)(ws + OFF_WO + j * SZ_WO) + (size_t)r * 1536 + h * 192 + 128 + c * 8) = (u32x4){0u, 0u, 0u, 0u}; }
        LAS float* scr = (LAS float*)(lds + wave * 16384);
        for (int it = GW; it < IT_END; it += NGW_) convert_item(it, scr, lane);
    }
    GSYNC();
    {
        int tidv = threadIdx.x; asm volatile("" : "+v"(tidv));
        const int tid2 = tidv, lane2 = tid2 & 63, wave2 = __builtin_amdgcn_readfirstlane(tid2 >> 6);
        for (int u = BX(); u < 408; u += GD()) bias_unit(u, lds, tid2, wave2, lane2);
        unsigned char* ws = ldws();
        first_aprime(ldp(I_X), ldp(I_CTX), ldp(I_GNORM), (const float*)(ws + OFF_MOD) + D, (bf16*)(ws + OFF_NH), (float*)(ws + OFF_SS), BX() * NWAVES + wave2, NGW_, lane2);
    }
    GSYNC();

#pragma unroll 1
    for (int it = 0; it < 3 * DEPTH; ++it) {
        {
            int itv = it; asm volatile("" : "+s"(itv));
            int tidv = threadIdx.x; asm volatile("" : "+v"(tidv));
            const int tid = tidv, lane = tid & 63, wave = __builtin_amdgcn_readfirstlane(tid >> 6);
            const int l = itv / 3, s = itv - 3 * l;
            const int kind = l & 1, j = l >> 1; const bool last = (l == DEPTH - 1);
            unsigned char* const ws = ldws();
            const int rows_out = (last && s >= 1) ? RL : RT;
            const float* SSc = (const float*)(ws + OFF_SS);
            if (s != 1) {
                const int m = l * 2 + (s >> 1);
                pg8::GemmT<2 * DFF, D, D> g{(const bf16*)(ws + OFF_NH), (const bf16*)(ws + OFF_WUP + m * SZ_WUP), rows_out}; pg8::StaticOrder S; S.init(rows_out, 2 * DFF, GD(), BX());
                pg8::EpiSwiGLU E{(bf16*)(ws + OFF_ACT), DFF, SSc, (const float*)(ws + OFF_BIAS) + BIAS_UP + (size_t)m * 17 * 5632};
                pg8::gemm_phase<pg8::EpiSwiGLU, pg8::StaticOrder, true, true>(lds, g, S, E);
                GSYNC();
            } else if (kind == 0) {
                { pg8::GemmT<3072, D, D> g{(const bf16*)(ws + OFF_NH), (const bf16*)(ws + OFF_WIN + j * SZ_WIN), rows_out}; pg8::StaticOrder S; S.init(rows_out, 3072, GD(), BX());
                  pg8::EpiWin E{(bf16*)(ws + OFF_BB), (bf16*)(ws + OFF_VV), SSc, (const float*)(ws + OFF_BIAS) + BIAS_WIN + (size_t)j * 17 * 3072};
                  pg8::gemm_phase<pg8::EpiWin, pg8::StaticOrder, true, true>(lds, g, S, E); }
                GSYNC();
                { conv_phase((const bf16*)(ws + OFF_BB), (const bf16*)(ws + OFF_VV), ldp(I_SCCONV) + (size_t)j * 3 * D, (bf16*)(ws + OFF_YY), BX() * 512 + tid, GD() * 512); }
                GSYNC();
            } else {
                { pg8::GemmT<512, D, D> g{(const bf16*)(ws + OFF_NH), (const bf16*)(ws + OFF_WA + j * SZ_WA), RT}; pg8::StaticOrder S; S.init(RT, 512, GD(), BX());
                  pg8::EpiBf16 E{(bf16*)(ws + OFF_CQKV), 512, nullptr, SSc, (const float*)(ws + OFF_BIAS) + BIAS_WA + (size_t)j * 17 * 512, (float*)(ws + OFF_STAT)};
                  pg8::gemm_phase<pg8::EpiBf16, pg8::StaticOrder, true, true>(lds, g, S, E); }
                GSYNC();
                { const float* RS4 = (const float*)(ws + OFF_STAT);
                  pg8::GemmT<1536, 256, 512> g{(const bf16*)(ws + OFF_CQKV), (const bf16*)(ws + OFF_WUQ + j * SZ_WUQ), rows_out}; pg8::StaticOrder S; S.init(rows_out, 1536, GD(), BX());
                  pg8::EpiBf16 E{(bf16*)(ws + OFF_Q), 1536, RS4, nullptr, nullptr, nullptr};
                  pg8::gemm_phase<pg8::EpiBf16, pg8::StaticOrder, true, true>(lds, g, S, E); }
                { const float* RS4 = (const float*)(ws + OFF_STAT);
                  pg8::GemmT<2048, 128, 512> g{(const bf16*)(ws + OFF_CQKV) + 256, (const bf16*)(ws + OFF_WUKV + j * SZ_WUKV), RT}; pg8::StaticOrder S; S.init(RT, 2048, GD(), BX());
                  pg8::EpiKV E{(bf16*)(ws + OFF_K), (bf16*)(ws + OFF_V), RS4};
                  pg8::gemm_phase<pg8::EpiKV, pg8::StaticOrder, true, true>(lds, g, S, E); }
                GSYNC();
#ifndef NO_FIN
                { finalize_phase((bf16*)(ws + OFF_Q), (bf16*)(ws + OFF_K), (const bf16*)(ws + OFF_CQKV), ldp(I_GQ) + j * 192, ldp(I_GK) + j * 192, (const float*)(ws + OFF_ROPE), false, GW, NGW_, lane); }
#endif
                GSYNC();
#ifndef NO_ATTN
                { const int G = GD(), bx = BX();
                  bf16* Qb = (bf16*)(ws + OFF_Q); const bf16* Kb = (const bf16*)(ws + OFF_K); const bf16* Vb = (const bf16*)(ws + OFF_V);
                  const int vcu = (G % 8 == 0) ? (bx % 8) * (G / 8) + bx / 8 : bx;
                  const int nunits = 1024 + (last ? 0 : 128); const float* gqp = ldp(I_GQ) + j * 192; const float* ropep = (const float*)(ws + OFF_ROPE);
                  for (int u = vcu; u < nunits; u += G) {
                      int b, h, q0, nt;
                      if (u < 1024) { b = u >> 6; h = (u >> 3) & 7; q0 = b * SEQ + (u & 7) * 256; nt = 36; }
                      else { b = (u - 1024) >> 3; h = (u - 1024) & 7; q0 = RL + b * CTXL; nt = 4; }
                      att::attn_unit(Qb, Kb, Vb, Qb, q0, h, nt, 4, RL + b * CTXL, b * SEQ, (char*)lds_raw, gqp, ropep, u < 1024);
                  } }
#endif
                GSYNC();
            }
            {
                const bool first = (itv == 0); const int m = l * 2 + (s >> 1);
                float* out = (float*)ldp_raw(I_OUT); float* hctx = (float*)(ws + OFF_HCTX);
                const int nx = itv + 1, ln = nx / 3, sn = nx - 3 * ln; const bool has_next = nx < 3 * DEPTH;
                const int half = (s != 1) ? 1 : 0;
                const bool split = (rows_out == RT) && (GD() == 256);
                float* part = (float*)(ws + OFF_BIG + ((s == 1 && kind == 0) ? 216 : 200) * MiB);
                const float* hin_c = first ? ldp(I_CTX) : hctx;
                const float* gatep = (const float*)(ws + OFF_MOD) + (size_t)l * NCOND * MODW + (3 * s + 2) * D;
                const float* scnp = (const float*)(ws + OFF_MOD) + (size_t)ln * NCOND * MODW + (3 * sn + 1) * D;
                const float* gnp = has_next ? ldp(I_GNORM) + (size_t)nx * D : nullptr;
#define MAKE_RES(NTF_) pg8::EpiRes E{first ? ldp(I_X) : out, hin_c, out, hctx, gatep, half, (bf16*)(ws + OFF_NH), (float*)(ws + OFF_SS), gnp, scnp, part, (NTF_) / 4}
#define RUN_RES(GT, AP, BP) do { GT g{AP, BP, rows_out}; MAKE_RES(GT::K / 64); \
                    if (split) { pg8::SplitCtxOrder S; S.init(RL, D, GD(), BX(), GT::K / 64); pg8::gemm_phase<pg8::EpiRes, pg8::SplitCtxOrder, true, true>(lds, g, S, E); } \
                    else { pg8::StaticOrder S; S.init(rows_out, D, GD(), BX()); pg8::gemm_phase<pg8::EpiRes, pg8::StaticOrder, true, true>(lds, g, S, E); } } while (0)
                if (s != 1) RUN_RES(GemmDn, (const bf16*)(ws + OFF_ACT), (const bf16*)(ws + OFF_WDN + m * SZ_WDN));
                else if (kind == 0) RUN_RES(GemmSq, (const bf16*)(ws + OFF_YY), (const bf16*)(ws + OFF_WOUT + j * SZ_SQ));
                else RUN_RES(GemmWo, (const bf16*)(ws + OFF_Q), (const bf16*)(ws + OFF_WO + j * SZ_WO));
#undef RUN_RES
#undef MAKE_RES
                if (split) {
                    GSYNC();
                    ctx_fix(hin_c, hctx, part, gatep + (size_t)16 * MODW, half ? 0.5f : 1.0f, (bf16*)(ws + OFF_NH), (float*)(ws + OFF_SS), gnp, scnp + (size_t)16 * MODW, GW, NGW_, lane);
                }
            }
            GSYNC();
        }
    }
}

extern "C" void kernel_launch(void* const* d_in, const int* in_sizes, int n_in, void* d_out, int out_size, void* d_ws, size_t ws_size, hipStream_t stream) {
    static int grid = 0;
    if (grid == 0) {
        if (n_in != N_IN || out_size != RL * D || ws_size < WS_END) { fprintf(stderr, "kernel_launch: unexpected shapes: n_in %d out %d ws %zu (need %zu)\n", n_in, out_size, ws_size, (size_t)WS_END); grid = -1; return; }
        int dev = 0, cus = 0, per_cu = 0;
        hipGetDevice(&dev); hipDeviceGetAttribute(&cus, hipDeviceAttributeMultiprocessorCount, dev);
        if (hipFuncSetAttribute((const void*)fwd_megakernel, hipFuncAttributeMaxDynamicSharedMemorySize, LDS_BYTES) != hipSuccess) { fprintf(stderr, "kernel_launch: hipFuncSetAttribute failed\n"); grid = -1; return; }
        if (hipOccupancyMaxActiveBlocksPerMultiprocessor(&per_cu, (const void*)fwd_megakernel, NWAVES * 64, LDS_BYTES) != hipSuccess || per_cu < 1) { fprintf(stderr, "kernel_launch: occupancy query says %d\n", per_cu); per_cu = 1; }
        (void)hipGetLastError();
        grid = cus * (per_cu > 1 ? 1 : per_cu);
        fprintf(stderr, "kernel_launch: grid %d (cus %d per_cu %d) ws %zu\n", grid, cus, per_cu, ws_size);
    }
    if (grid < 0) return;
    if (hipMemsetAsync((char*)d_ws + OFF_CTL, 0, CTL_BYTES, stream) != hipSuccess) { fprintf(stderr, "kernel_launch: memset failed\n"); return; }
    Params p{};
    for (int i = 0; i < N_IN; ++i) p.in[i] = (const float*)d_in[i];
    p.out = (float*)d_out; p.ws = (unsigned char*)d_ws; p.pad0 = 0; p.pad1 = 0;
    void* args[] = {&p};
    hipError_t e = hipLaunchCooperativeKernel((const void*)fwd_megakernel, dim3(grid), dim3(NWAVES * 64), args, LDS_BYTES, stream);
    if (e != hipSuccess) fprintf(stderr, "cooperative launch failed: %s (grid %d)\n", hipGetErrorString(e), grid);
}
```

```cpp
#include <hip/hip_runtime.h>
#include <hip/hip_cooperative_groups.h>
#include <cstdio>
#include <cstdint>
namespace cg = cooperative_groups;
namespace pg8 {
#define PG8_LAS __attribute__((address_space(3)))
typedef unsigned short bf16_t;
typedef short bf16x8 __attribute__((ext_vector_type(8)));
typedef float f32x4 __attribute__((ext_vector_type(4)));
typedef unsigned u32x4 __attribute__((ext_vector_type(4)));
typedef unsigned u32x2 __attribute__((ext_vector_type(2)));
constexpr int BM = 256, BK = 64, HALF = 128, HTB = HALF * BK * 2  , STAGE_BYTES = 8 * HTB, NXCD = 8, WGM = 8;

__device__ __forceinline__ float xrow_sum(float v) {
    { auto r_ = __builtin_amdgcn_permlane16_swap(__float_as_uint(v), __float_as_uint(v), false, false); v = __uint_as_float(r_[0]) + __uint_as_float(r_[1]); }
    { auto r_ = __builtin_amdgcn_permlane32_swap(__float_as_uint(v), __float_as_uint(v), false, false); v = __uint_as_float(r_[0]) + __uint_as_float(r_[1]); }
    return v;
}
__host__ __device__ __forceinline__ int lds_byte(int r, int c) { const int st = (r >> 4) * 2 + (c >> 5), rr = r & 15, cc = c & 31, ob = rr * 64 + cc * 2; return st * 1024 + (ob ^ (((ob >> 9) & 1) << 5)); }
__host__ __device__ __forceinline__ void stage_rc(int b, int& R, int& C) { const int st = b / 1024, sb = b % 1024, swz = sb ^ (((sb >> 9) & 1) << 5); R = (st >> 1) * 16 + swz / 64; C = (st & 1) * 32 + (swz % 64) / 2; }
__host__ __device__ __forceinline__ int perm32(int rho) { const int n = rho >> 4, i = rho & 15; return 8 * (i >> 2) + 4 * n + (i & 3); }

struct Unit { int pm, pn, k0, nt; };
template <int N_, int K_, int LDA_> struct GemmT { const bf16_t* A; const bf16_t* Bt; int M; static constexpr int N = N_, K = K_, lda = LDA_; };

struct StaticOrder {
    int nM, nN, nwg, G, c;
    __host__ __device__ void init(int M, int N, int G_, int c_) { nM = M / BM; nN = N / BM; nwg = nM * nN; G = G_; c = c_; }
    __host__ __device__ bool next(int i, Unit& u) const {
        const long L = (long)i * G + c; if (L >= nwg) return false;
        int wgid = (int)L; { const int q = nwg / NXCD, r = nwg % NXCD, xcd = wgid % NXCD, off = wgid / NXCD; wgid = (xcd < r ? xcd * (q + 1) : r * (q + 1) + (xcd - r) * q) + off; }
        const int nig = WGM * nN, gid = wgid / nig, fm = gid * WGM, gsz = (nM - fm) < WGM ? (nM - fm) : WGM;
        u.pm = fm + ((wgid % nig) % gsz); u.pn = (wgid % nig) / gsz; u.k0 = 0; u.nt = 0; return true;
    }
    __device__ __forceinline__ void a_ready(const Unit&) const {}
    __device__ __forceinline__ void done(const Unit&) const {}
};


struct SplitCtxOrder {
    StaticOrder lat; int c, ntf;
    __host__ __device__ void init(int Mlat, int N, int G_, int c_, int ntf_) { lat.init(Mlat, N, G_, c_); c = c_; ntf = ntf_; }
    __host__ __device__ bool next(int i, Unit& u) const {
        if (i < 2) return lat.next(i, u);
        if (i > 2) return false;
        const int cu = c >> 2, kq = c & 3, base = ntf >> 2, odd = base & 1;
        u.pm = 128 + (cu >> 2); u.pn = cu & 3;
        u.k0 = kq * base + (odd ? (kq & 1) : 0); u.nt = base + (odd ? ((kq & 1) ? -1 : 1) : 0);
        return true;
    }
    __device__ __forceinline__ void a_ready(const Unit&) const {}
    __device__ __forceinline__ void done(const Unit&) const {}
};
__device__ __forceinline__ unsigned cvt_pk_bf16(float lo, float hi) { unsigned r; asm volatile("v_cvt_pk_bf16_f32 %0, %1, %2" : "=v"(r) : "v"(lo), "v"(hi)); return r; }
__device__ __forceinline__ u32x4 pack8(const f32x4 v0, const f32x4 v1) { u32x4 w; w.x = cvt_pk_bf16(v0[0], v0[1]); w.y = cvt_pk_bf16(v0[2], v0[3]); w.z = cvt_pk_bf16(v1[0], v1[1]); w.w = cvt_pk_bf16(v1[2], v1[3]); return w; }
__device__ __forceinline__ float silu_f(float a) { return a * __builtin_amdgcn_rcpf(1.0f + __builtin_amdgcn_exp2f(-1.4426950408889634f * a)); }

#define PG8_GAS __attribute__((address_space(1)))
constexpr int RL_ROWS = 32768;
__device__ __forceinline__ float row_rs(const float* ssp, int row) { const PG8_GAS f32x4* p = (const PG8_GAS f32x4*)(ssp + (size_t)row * 16); const f32x4 a = p[0], b = p[1], c = p[2], d = p[3];
    const float s = ((a[0] + a[1]) + (a[2] + a[3])) + ((b[0] + b[1]) + (b[2] + b[3])) + (((c[0] + c[1]) + (c[2] + c[3])) + ((d[0] + d[1]) + (d[2] + d[3]))); return rsqrtf(s * (1.0f / 1024.0f) + 1e-6f); }

constexpr int RS_LDS_OFF = 131072;
__device__ __forceinline__ void tile_rs_build(const float* ss, int rowt, int wr, int wc, int fr, int fq) {
    const int t = (wr * 4 + wc) * 64 + fq * 16 + fr;
    if (t < 256) ((PG8_LAS float*)(uintptr_t)RS_LDS_OFF)[t] = row_rs(ss, rowt + t);
    asm volatile("s_waitcnt lgkmcnt(0)" ::: "memory"); __builtin_amdgcn_s_barrier(); asm volatile("" ::: "memory");
}
__device__ __forceinline__ float tile_rs(int rloc) { return ((const PG8_LAS float*)(uintptr_t)RS_LDS_OFF)[rloc]; }
struct EpiSwiGLU {
    static constexpr bool PERM = true, AFTER_DRAIN = false;
    bf16_t* O; int ldc; const float* ss; const float* bias;
    __device__ __forceinline__ void operator()(const f32x4 (&acc)[2][2][4][2], const Unit& u, int wr, int wc, int fr, int fq) const {
        const int rowt = u.pm * BM, cond = rowt < RL_ROWS ? (rowt >> 11) : 16;
        const int row0 = rowt + wr * 64 + fr, col0 = u.pn * HALF + wc * 32 + 8 * fq;
        const float* bp = bias + (size_t)cond * (2 * ldc) + u.pn * BM + wc * 32 + 8 * fq;
        f32x4 bv[2][2];
#pragma unroll
        for (int bj = 0; bj < 2; ++bj)
#pragma unroll
            for (int n = 0; n < 2; ++n) bv[bj][n] = *(const f32x4*)(bp + bj * HALF + 4 * n);
        tile_rs_build(ss, rowt, wr, wc, fr, fq);
#pragma unroll
        for (int ai = 0; ai < 2; ++ai)
#pragma unroll
            for (int m = 0; m < 4; ++m) { const int row = row0 + ai * HALF + m * 16; const float rs = tile_rs(row - rowt); bf16_t* rowp = O + (size_t)row * ldc + col0;
                f32x4 v0, v1;
#pragma unroll
                for (int j = 0; j < 4; ++j) { v0[j] = silu_f(acc[ai][0][m][0][j] * rs + bv[0][0][j]) * (acc[ai][1][m][0][j] * rs + bv[1][0][j]); v1[j] = silu_f(acc[ai][0][m][1][j] * rs + bv[0][1][j]) * (acc[ai][1][m][1][j] * rs + bv[1][1][j]); }
                *(PG8_GAS u32x4*)rowp = pack8(v0, v1); }
    }
};
struct EpiBf16 {
    static constexpr bool PERM = true, AFTER_DRAIN = false;
    bf16_t* O; int ldc; const float* rs4; const float* ss; const float* bias; float* sqout;
    __device__ __forceinline__ void operator()(const f32x4 (&acc)[2][2][4][2], const Unit& u, int wr, int wc, int fr, int fq) const {
        const int rowt = u.pm * BM, cond = rowt < RL_ROWS ? (rowt >> 11) : 16;
        const int row0 = rowt + wr * 64 + fr, col0 = u.pn * BM + wc * 32 + 8 * fq;
        f32x4 bv[2][2];
#pragma unroll
        for (int bj = 0; bj < 2; ++bj)
#pragma unroll
            for (int n = 0; n < 2; ++n) bv[bj][n] = bias ? *(const f32x4*)(bias + (size_t)cond * ldc + col0 + bj * HALF + 4 * n) : (f32x4){0.f, 0.f, 0.f, 0.f};
        if (!rs4) tile_rs_build(ss, rowt, wr, wc, fr, fq);
#pragma unroll
        for (int ai = 0; ai < 2; ++ai)
#pragma unroll
            for (int m = 0; m < 4; ++m) { const int row = row0 + ai * HALF + m * 16; float s;
                if (rs4) { const f32x4 p = *(const PG8_GAS f32x4*)(rs4 + (size_t)row * 8); s = rsqrtf(((p[0] + p[1]) + (p[2] + p[3])) * (1.0f / 256.0f) + 1e-6f); } else s = tile_rs(row - rowt);
                bf16_t* rowp = O + (size_t)row * ldc + col0; float sq = 0.f;
#pragma unroll
                for (int bj = 0; bj < 2; ++bj) { const f32x4 v0 = acc[ai][bj][m][0] * s + bv[bj][0], v1 = acc[ai][bj][m][1] * s + bv[bj][1]; *(PG8_GAS u32x4*)(rowp + bj * HALF) = pack8(v0, v1);
                    if (bj == 0 || u.pn == 0) sq += ((v0[0] * v0[0] + v0[1] * v0[1]) + (v0[2] * v0[2] + v0[3] * v0[3])) + ((v1[0] * v1[0] + v1[1] * v1[1]) + (v1[2] * v1[2] + v1[3] * v1[3])); }
                if (sqout) { sq = xrow_sum(sq); if (fq == 0 && u.pn < 2) sqout[(size_t)row * 8 + u.pn * 4 + wc] = sq; } }
    }
};
struct EpiKV {
    static constexpr bool PERM = true, AFTER_DRAIN = false;
    bf16_t* Kb; bf16_t* Vb; const float* rs4;
    __device__ __forceinline__ void operator()(const f32x4 (&acc)[2][2][4][2], const Unit& u, int wr, int wc, int fr, int fq) const {
        const int row0 = u.pm * BM + wr * 64 + fr, c0 = wc * 32 + 8 * fq;
#pragma unroll
        for (int ai = 0; ai < 2; ++ai)
#pragma unroll
            for (int m = 0; m < 4; ++m) { const int row = row0 + ai * HALF + m * 16; const f32x4 p = *(const PG8_GAS f32x4*)(rs4 + (size_t)row * 8 + 4); const float s = rsqrtf(((p[0] + p[1]) + (p[2] + p[3])) * (1.0f / 128.0f) + 1e-6f);
                *(PG8_GAS u32x4*)(Kb + (size_t)row * 1536 + u.pn * 192 + c0) = pack8(acc[ai][0][m][0] * s, acc[ai][0][m][1] * s);
                *(PG8_GAS u32x4*)(Vb + (size_t)row * 1024 + u.pn * 128 + c0) = pack8(acc[ai][1][m][0] * s, acc[ai][1][m][1] * s); }
    }
};
struct EpiWin {
    static constexpr bool PERM = true, AFTER_DRAIN = false;
    bf16_t* Bb; bf16_t* Vb; const float* ss; const float* bias;
    __device__ __forceinline__ void operator()(const f32x4 (&acc)[2][2][4][2], const Unit& u, int wr, int wc, int fr, int fq) const {
        const int rowt = u.pm * BM, cond = rowt < RL_ROWS ? (rowt >> 11) : 16;
        const int row0 = rowt + wr * 64 + fr, c0 = wc * 32 + 8 * fq;
        const float* bp = bias + (size_t)cond * 3072 + u.pn * BM + c0;
        f32x4 bv[2][2];
#pragma unroll
        for (int bj = 0; bj < 2; ++bj)
#pragma unroll
            for (int n = 0; n < 2; ++n) bv[bj][n] = *(const f32x4*)(bp + bj * HALF + 4 * n);
        tile_rs_build(ss, rowt, wr, wc, fr, fq);
        if (u.pn < 4) {
#pragma unroll
            for (int ai = 0; ai < 2; ++ai)
#pragma unroll
                for (int m = 0; m < 4; ++m) { const int row = row0 + ai * HALF + m * 16; const float rs = tile_rs(row - rowt); bf16_t* rowp = Bb + (size_t)row * 1024 + u.pn * BM + c0;
#pragma unroll
                    for (int bj = 0; bj < 2; ++bj) *(PG8_GAS u32x4*)(rowp + bj * HALF) = pack8(acc[ai][bj][m][0] * rs + bv[bj][0], acc[ai][bj][m][1] * rs + bv[bj][1]); }
        } else {
#pragma unroll
            for (int ai = 0; ai < 2; ++ai)
#pragma unroll
                for (int m = 0; m < 4; ++m) { const int row = row0 + ai * HALF + m * 16; const float rs = tile_rs(row - rowt); bf16_t* rowp = Vb + (size_t)row * 1024 + (u.pn - 4) * HALF + c0;
                    *(PG8_GAS u32x4*)rowp = pack8((acc[ai][0][m][0] * rs + bv[0][0]) * (acc[ai][1][m][0] * rs + bv[1][0]), (acc[ai][0][m][1] * rs + bv[0][1]) * (acc[ai][1][m][1] * rs + bv[1][1])); }
        }
    }
};
struct EpiRes {
    static constexpr bool PERM = false, AFTER_DRAIN = false;
    const float* hin_l; const float* hin_c; float* hout_l; float* hout_c; const float* gate;   int half;
    bf16_t* NHn; float* SSn; const float* gn; const float* scn;
    float* part; int kbase;
    __device__ __forceinline__ void operator()(const f32x4 (&acc)[2][2][4][2], const Unit& u, int wr, int wc, int fr, int fq) const {
        if (u.nt != 0) {
            PG8_GAS bf16_t* pp = (PG8_GAS bf16_t*)((bf16_t*)part + ((size_t)(u.k0 / kbase) * 4096 + (size_t)(u.pm * BM - RL_ROWS)) * 1024); const unsigned o0 = (unsigned)((wr * 64 + fr) * 1024 + u.pn * BM + wc * 32 + 4 * fq);
#pragma unroll
            for (int ai = 0; ai < 2; ++ai)
#pragma unroll
                for (int m = 0; m < 4; ++m)
#pragma unroll
                    for (int bj = 0; bj < 2; ++bj)
#pragma unroll
                        for (int n = 0; n < 2; ++n) { const f32x4 a_ = acc[ai][bj][m][n]; u32x2 w_; w_.x = cvt_pk_bf16(a_[0], a_[1]); w_.y = cvt_pk_bf16(a_[2], a_[3]); *(PG8_GAS u32x2*)(pp + o0 + (unsigned)((ai * HALF + m * 16) * 1024 + bj * HALF + n * 16)) = w_; }
            return;
        }
        const int rowt = u.pm * BM; const bool lat = rowt < RL_ROWS; const int cond = lat ? (rowt >> 11) : 16;
        const PG8_GAS float* hi = (const PG8_GAS float*)(lat ? hin_l + (size_t)rowt * 1024 : hin_c + (size_t)(rowt - RL_ROWS) * 1024);
        PG8_GAS float* ho = (PG8_GAS float*)(lat ? hout_l + (size_t)rowt * 1024 : hout_c + (size_t)(rowt - RL_ROWS) * 1024);
        PG8_GAS bf16_t* nht = (PG8_GAS bf16_t*)(NHn + (size_t)rowt * 1024); PG8_GAS float* sst = (PG8_GAS float*)(SSn + (size_t)rowt * 16);
        const int col0 = u.pn * BM + wc * 32 + 4 * fq; const float* gp = gate + (size_t)cond * 9216 + col0;
        f32x4 gv[2][2], gsv[2][2]; const float gs = half ? 0.5f : 1.0f; const bool nxt = gn != nullptr;
#pragma unroll
        for (int bj = 0; bj < 2; ++bj)
#pragma unroll
            for (int n = 0; n < 2; ++n) { gv[bj][n] = *(const f32x4*)(gp + bj * HALF + n * 16) * gs;
                gsv[bj][n] = nxt ? *(const f32x4*)(gn + col0 + bj * HALF + n * 16) * (*(const f32x4*)(scn + (size_t)cond * 9216 + col0 + bj * HALF + n * 16) + 1.0f) : (f32x4){0.f, 0.f, 0.f, 0.f}; }
        const unsigned off0 = (unsigned)((wr * 64 + fr) * 1024 + col0);
#pragma unroll
        for (int g2 = 0; g2 < 4; ++g2) {
            const int ai = g2 >> 1, mb = (g2 & 1) * 2;
            f32x4 pre[2][2][2];
#pragma unroll
            for (int mm = 0; mm < 2; ++mm)
#pragma unroll
                for (int bj = 0; bj < 2; ++bj)
#pragma unroll
                    for (int n = 0; n < 2; ++n) pre[mm][bj][n] = *(const PG8_GAS f32x4*)(hi + off0 + (unsigned)((ai * HALF + (mb + mm) * 16) * 1024 + bj * HALF + n * 16));
#pragma unroll
            for (int mm = 0; mm < 2; ++mm) { const int m = mb + mm; const unsigned off = off0 + (unsigned)((ai * HALF + m * 16) * 1024); float sq = 0.f;
#pragma unroll
                for (int bj = 0; bj < 2; ++bj)
#pragma unroll
                    for (int n = 0; n < 2; ++n) { const unsigned o_ = off + (unsigned)(bj * HALF + n * 16);
                        const f32x4 o = pre[mm][bj][n] + gv[bj][n] * acc[ai][bj][m][n]; *(PG8_GAS f32x4*)(ho + o_) = o;
                        if (nxt) { const f32x4 a = o * gsv[bj][n]; u32x2 w; w.x = cvt_pk_bf16(a[0], a[1]); w.y = cvt_pk_bf16(a[2], a[3]);
                            *(PG8_GAS u32x2*)(nht + o_) = w; sq += (o[0] * o[0] + o[1] * o[1]) + (o[2] * o[2] + o[3] * o[3]); } }
                if (nxt) { sq = xrow_sum(sq); if (fq == 0) sst[(size_t)(off >> 10) * 16 + u.pn * 4 + wc] = sq; } }
        }
    }
};

template <class Epi, class Sched, bool ALIGN_EPI, bool SP2, class Gm>
__device__ __forceinline__ void gemm_phase(PG8_LAS unsigned char* lds, const Gm g, const Sched& S, const Epi& E) {
    int tid = threadIdx.x; asm volatile("" : "+v"(tid));
    const int wid = __builtin_amdgcn_readfirstlane(tid >> 6), lane = tid & 63, wr = wid >> 2, wc = wid & 3, fr = lane & 15, fq = lane >> 4;
    constexpr int K = Gm::K, NTF = K / BK;
    unsigned voffA[2], voffB[2];
#pragma unroll
    for (int i = 0; i < 2; ++i) { int R, C; stage_rc(tid * 16 + i * 8192, R, C); const int Rb = Epi::PERM ? ((R & ~31) + perm32(R & 31)) : R;
        voffA[i] = (unsigned)(R * Gm::lda + C) * 2u; voffB[i] = (unsigned)(Rb * K + C) * 2u; }
    constexpr size_t kstep = (size_t)(BK * 2);
    constexpr size_t hstepA = (size_t)HALF * Gm::lda * 2, hstepB = (size_t)HALF * K * 2;
    constexpr size_t tstepA = 2 * hstepA, tstepB = 2 * hstepB;
    const unsigned ldsw = (unsigned)wid * 1024u;
    const int aoff = lds_byte(wr * 64 + fr, fq * 8), boff = lds_byte(wc * 32 + fr, fq * 8);
#define PG8_SA(b, h) (((b) * 2 + (h)) * HTB)
#define PG8_SB(b, h) ((4 + (b) * 2 + (h)) * HTB)
#define PG8_STAGE(bufoff, gbase, voff) do { _Pragma("unroll") for (int _i = 0; _i < 2; ++_i) \
        __builtin_amdgcn_global_load_lds((const unsigned*)((const char*)(gbase) + (voff)[_i]), (PG8_LAS unsigned*)(lds + (bufoff) + ldsw + _i * 8192), 16, 0, 0); } while (0)
#define PG8_LDA(dst, b, h) do { _Pragma("unroll") for (int m = 0; m < 4; ++m) _Pragma("unroll") for (int k = 0; k < 2; ++k) dst[m][k] = *(const PG8_LAS bf16x8*)(lds + PG8_SA(b, h) + aoff + m * 2048 + k * 1024); } while (0)
#define PG8_LDB(dst, b, h) do { _Pragma("unroll") for (int n = 0; n < 2; ++n) _Pragma("unroll") for (int k = 0; k < 2; ++k) dst[n][k] = *(const PG8_LAS bf16x8*)(lds + PG8_SB(b, h) + boff + n * 2048 + k * 1024); } while (0)
#define PG8_MMA(ai, bj, At, Bt) do { __builtin_amdgcn_s_setprio(1); _Pragma("unroll") for (int m = 0; m < 4; ++m) _Pragma("unroll") for (int n = 0; n < 2; ++n) _Pragma("unroll") for (int k = 0; k < 2; ++k) \
        acc[ai][bj][m][n] = __builtin_amdgcn_mfma_f32_16x16x32_bf16(Bt[n][k], At[m][k], acc[ai][bj][m][n], 0, 0, 0); __builtin_amdgcn_s_setprio(0); } while (0)
#define PG8_WAIT_V(n) asm volatile("s_waitcnt vmcnt(" #n ")" ::: "memory")
#define PG8_WAIT_L(n) asm volatile("s_waitcnt lgkmcnt(" #n ")" ::: "memory")
#define PG8_BAR __builtin_amdgcn_s_barrier()
#define PG8_SCHED __builtin_amdgcn_sched_barrier(0)
    Unit cur, nxt; int ui = 0;
    if (!S.next(0, cur)) return;
    int nt = cur.nt ? cur.nt : NTF;
    f32x4 acc[2][2][4][2];
#pragma unroll
    for (int a = 0; a < 2; ++a)
#pragma unroll
        for (int b = 0; b < 2; ++b)
#pragma unroll
            for (int m = 0; m < 4; ++m)
#pragma unroll
                for (int n = 0; n < 2; ++n) acc[a][b][m][n] = (f32x4){0.f, 0.f, 0.f, 0.f};
    bf16x8 At[4][2], B0[2][2], B1[2][2];
    const char* cA = (const char*)g.A + (size_t)cur.pm * tstepA + (size_t)cur.k0 * kstep; const char* cB = (const char*)g.Bt + (size_t)cur.pn * tstepB + (size_t)cur.k0 * kstep;
    S.a_ready(cur);
    if constexpr (SP2) {
        PG8_STAGE(PG8_SB(0, 0), cB, voffB); PG8_STAGE(PG8_SB(0, 1), cB + hstepB, voffB); PG8_STAGE(PG8_SA(0, 0), cA, voffA); PG8_STAGE(PG8_SA(0, 1), cA + hstepA, voffA);
        if (wr == 1) PG8_BAR;
        PG8_WAIT_V(2); PG8_BAR;
        PG8_STAGE(PG8_SB(1, 0), cB + kstep, voffB); PG8_STAGE(PG8_SA(1, 0), cA + kstep, voffA); PG8_STAGE(PG8_SB(1, 1), cB + hstepB + kstep, voffB);
        PG8_WAIT_V(6); PG8_BAR;
    } else {
        PG8_STAGE(PG8_SB(0, 0), cB, voffB); PG8_STAGE(PG8_SA(0, 0), cA, voffA); PG8_STAGE(PG8_SB(0, 1), cB + hstepB, voffB); PG8_STAGE(PG8_SA(0, 1), cA + hstepA, voffA);
        if (wr == 1) PG8_BAR;
        PG8_WAIT_V(4); PG8_BAR;
        PG8_STAGE(PG8_SB(1, 0), cB + kstep, voffB); PG8_STAGE(PG8_SA(1, 0), cA + kstep, voffA); PG8_STAGE(PG8_SB(1, 1), cB + hstepB + kstep, voffB);
        PG8_WAIT_V(6); PG8_BAR;
    }
    for (;;) {
        const bool has_next = S.next(ui + 1, nxt);
        const char* nA = has_next ? (const char*)g.A + (size_t)nxt.pm * tstepA + (size_t)nxt.k0 * kstep : cA; const char* nB = has_next ? (const char*)g.Bt + (size_t)nxt.pn * tstepB + (size_t)nxt.k0 * kstep : cB;
        for (int t = 0; t < nt; t += 2) {
            const bool last = (t == nt - 2);
            const char* a1 = cA + (size_t)(t + 1) * kstep;
            const char* a2 = last ? nA : cA + (size_t)(t + 2) * kstep; const char* b2 = last ? nB : cB + (size_t)(t + 2) * kstep;
            const char* a3 = a2 + kstep; const char* b3 = b2 + kstep;
            if (last && has_next) S.a_ready(nxt);
            if constexpr (SP2) {
            PG8_LDB(B0, 0, 0); PG8_LDB(B1, 0, 1); PG8_SCHED; PG8_LDA(At, 0, 0); PG8_STAGE(PG8_SA(1, 1), a1 + hstepA, voffA);
            PG8_WAIT_V(8); PG8_WAIT_L(0); PG8_BAR; PG8_MMA(0, 0, At, B0); PG8_MMA(0, 1, At, B1); PG8_BAR; PG8_SCHED;
            PG8_LDA(At, 0, 1); PG8_STAGE(PG8_SB(0, 0), b2, voffB); PG8_STAGE(PG8_SB(0, 1), b2 + hstepB, voffB); PG8_STAGE(PG8_SA(0, 0), a2, voffA);
            PG8_WAIT_V(8); PG8_WAIT_L(0); PG8_BAR; PG8_MMA(1, 0, At, B0); PG8_MMA(1, 1, At, B1); PG8_BAR; PG8_SCHED;
            PG8_LDB(B0, 1, 0); PG8_LDB(B1, 1, 1); PG8_SCHED; PG8_LDA(At, 1, 0); PG8_STAGE(PG8_SA(0, 1), a2 + hstepA, voffA);
            PG8_WAIT_V(8); PG8_WAIT_L(0); PG8_BAR; PG8_MMA(0, 0, At, B0); PG8_MMA(0, 1, At, B1); PG8_BAR; PG8_SCHED;
            PG8_LDA(At, 1, 1); PG8_STAGE(PG8_SB(1, 0), b3, voffB); PG8_STAGE(PG8_SB(1, 1), b3 + hstepB, voffB); PG8_STAGE(PG8_SA(1, 0), a3, voffA);
            PG8_WAIT_V(8); PG8_WAIT_L(0); PG8_BAR; PG8_MMA(1, 0, At, B0); PG8_MMA(1, 1, At, B1); PG8_BAR; PG8_SCHED;
            } else {
            PG8_LDB(B0, 0, 0); PG8_SCHED; PG8_LDA(At, 0, 0); PG8_STAGE(PG8_SA(1, 1), a1 + hstepA, voffA);
            PG8_WAIT_L(8); PG8_BAR; PG8_WAIT_L(0); PG8_MMA(0, 0, At, B0); PG8_BAR; PG8_SCHED;
            PG8_LDB(B1, 0, 1); PG8_STAGE(PG8_SB(0, 0), b2, voffB);
            PG8_BAR; PG8_WAIT_L(0); PG8_MMA(0, 1, At, B1); PG8_BAR;
            PG8_LDA(At, 0, 1); PG8_STAGE(PG8_SA(0, 0), a2, voffA);
            PG8_BAR; PG8_WAIT_L(0); PG8_MMA(1, 0, At, B0); PG8_BAR; PG8_SCHED;
            PG8_STAGE(PG8_SB(0, 1), b2 + hstepB, voffB);
            PG8_WAIT_V(6); PG8_BAR; PG8_MMA(1, 1, At, B1); PG8_BAR;
            PG8_LDB(B0, 1, 0); PG8_SCHED; PG8_LDA(At, 1, 0); PG8_STAGE(PG8_SA(0, 1), a2 + hstepA, voffA);
            PG8_WAIT_L(8); PG8_BAR; PG8_WAIT_L(0); PG8_MMA(0, 0, At, B0); PG8_BAR; PG8_SCHED;
            PG8_LDB(B1, 1, 1); PG8_STAGE(PG8_SB(1, 0), b3, voffB);
            PG8_BAR; PG8_WAIT_L(0); PG8_MMA(0, 1, At, B1); PG8_BAR;
            PG8_LDA(At, 1, 1); PG8_STAGE(PG8_SA(1, 0), a3, voffA);
            PG8_BAR; PG8_WAIT_L(0); PG8_MMA(1, 0, At, B0); PG8_BAR; PG8_SCHED;
            PG8_STAGE(PG8_SB(1, 1), b3 + hstepB, voffB);
            PG8_WAIT_V(6); PG8_BAR; PG8_MMA(1, 1, At, B1); PG8_BAR;
            }
        }
        if constexpr (ALIGN_EPI) { if (wr == 0) PG8_BAR; }
        if constexpr (!Epi::AFTER_DRAIN) { E(acc, cur, wr, wc, fr, fq); S.done(cur); }
        if (!has_next) break;
#pragma unroll
        for (int a = 0; a < 2; ++a)
#pragma unroll
            for (int b = 0; b < 2; ++b)
#pragma unroll
                for (int m = 0; m < 4; ++m)
#pragma unroll
                    for (int n = 0; n < 2; ++n) acc[a][b][m][n] = (f32x4){0.f, 0.f, 0.f, 0.f};
        cur = nxt; cA = nA; cB = nB; ++ui; nt = cur.nt ? cur.nt : NTF;
        if constexpr (ALIGN_EPI) { if (wr == 1) PG8_BAR; }
    }
    PG8_WAIT_V(0);
    if constexpr (!ALIGN_EPI) { if (wr == 0) PG8_BAR; }
    PG8_BAR;
    if constexpr (Epi::AFTER_DRAIN) { E.fused(acc, cur, wr, wc, fr, fq, lds, wid, lane); S.done(cur); }
#undef PG8_SA
#undef PG8_SB
#undef PG8_STAGE
#undef PG8_LDA
#undef PG8_LDB
#undef PG8_MMA
#undef PG8_WAIT_V
#undef PG8_WAIT_L
#undef PG8_BAR
#undef PG8_SCHED
}
}
namespace att {
using bf16x8 = __attribute__((ext_vector_type(8))) short;
using s16x4  = __attribute__((ext_vector_type(4))) short;
using f32x16 = __attribute__((ext_vector_type(16))) float;
using u32x4  = __attribute__((ext_vector_type(4))) unsigned;
typedef unsigned short bf16_t;
#define ATT_GAS __attribute__((address_space(1)))
constexpr int DQK = 192, DV = 128, NW = 8, QBLK = 32, KVBLK = 64;
constexpr int LDQ = 1536, LDKK = 1536, LDV = 1024, LDO = 1536;
constexpr int QREG = 6;
constexpr int SHM_V = KVBLK * DV * 2, SHM_K = KVBLK * DQK * 2, SHM_WS = NW * 64 * 4, SHM_QOFF = 2 * SHM_V + 2 * SHM_K + SHM_WS, SHM_ATTN = SHM_QOFF + NW * (12 - QREG) * 1024;
typedef float f32x4_ __attribute__((ext_vector_type(4)));
constexpr float QSCALE = 0.07216878364870322f * 1.4426950408889634f;
constexpr float THR = 8.0f;
#define KSWZ(row, colB) ((row) * 384 + ((colB) ^ (((row) & 7) << 4)))
#define SBAR() __builtin_amdgcn_sched_barrier(0)
__device__ __forceinline__ int crow(int r, int hi) { return (r & 3) + 8 * (r >> 2) + 4 * hi; }
__device__ __forceinline__ unsigned cvtpk(float lo, float hi) { unsigned r; asm volatile("v_cvt_pk_bf16_f32 %0, %1, %2" : "=v"(r) : "v"(lo), "v"(hi)); return r; }

__device__ __forceinline__ void partialSM(f32x16& p0, f32x16& p1, float& m_reg, float& mn, float& alpha) {
  float pmax = p0[0];
#pragma unroll
  for (int r = 1; r < 16; ++r) pmax = fmaxf(pmax, p0[r]);
#pragma unroll
  for (int r = 0; r < 16; ++r) pmax = fmaxf(pmax, p1[r]);
  { auto rr = __builtin_amdgcn_permlane32_swap(__float_as_uint(pmax), __float_as_uint(pmax), false, false);
    pmax = fmaxf(__uint_as_float(rr[0]), __uint_as_float(rr[1])); }
  if (__builtin_expect(__all(pmax - m_reg <= THR), 1)) { mn = m_reg; alpha = 1.f; }
  else { mn = fmaxf(m_reg, pmax); alpha = __builtin_amdgcn_exp2f(m_reg - mn); m_reg = mn; }
#pragma unroll
  for (int r = 0; r < 16; ++r) p0[r] = p0[r] - mn;
#pragma unroll
  for (int r = 0; r < 16; ++r) p1[r] = p1[r] - mn;
#pragma unroll
  for (int r = 0; r < 16; ++r) p0[r] = __builtin_amdgcn_exp2f(p0[r]);
}
__device__ __forceinline__ void finishSM(f32x16& p0, f32x16& p1, float alpha, float& l_reg, bf16x8& pa0, bf16x8& pa1, bf16x8& pa2, bf16x8& pa3) {
#pragma unroll
  for (int r = 0; r < 16; ++r) p1[r] = __builtin_amdgcn_exp2f(p1[r]);
  float ps = 0;
#pragma unroll
  for (int r = 0; r < 16; ++r) ps += p0[r];
#pragma unroll
  for (int r = 0; r < 16; ++r) ps += p1[r];
  { auto rr = __builtin_amdgcn_permlane32_swap(__float_as_uint(ps), __float_as_uint(ps), false, false);
    ps = __uint_as_float(rr[0]) + __uint_as_float(rr[1]); }
  l_reg = l_reg * alpha + ps;
#define PK4(P, BASE, OUT) do { unsigned a0 = cvtpk(P[BASE + 0], P[BASE + 1]), a1 = cvtpk(P[BASE + 2], P[BASE + 3]);   \
    unsigned b0 = cvtpk(P[BASE + 4], P[BASE + 5]), b1 = cvtpk(P[BASE + 6], P[BASE + 7]);                              \
    auto r0 = __builtin_amdgcn_permlane32_swap(a0, b0, false, false); auto r1 = __builtin_amdgcn_permlane32_swap(a1, b1, false, false); \
    u32x4 w = {r0[0], r1[0], r0[1], r1[1]}; OUT = __builtin_bit_cast(bf16x8, w); } while (0)
  PK4(p0, 0, pa0); PK4(p0, 8, pa1); PK4(p1, 0, pa2); PK4(p1, 8, pa3);
#undef PK4
}
__device__ __forceinline__ void qkt(f32x16& p0, f32x16& p1, const char* Ks, const bf16x8* qr, const char* ql, int r32, int hi) {
  p0 = f32x16{}; p1 = f32x16{};
#pragma unroll
  for (int d0 = 0; d0 < 12; ++d0) { const int cb = (d0 * 16 + hi * 8) * 2;
    bf16x8 b0 = *reinterpret_cast<const bf16x8*>(Ks + KSWZ(r32, cb));
    bf16x8 b1 = *reinterpret_cast<const bf16x8*>(Ks + KSWZ(32 + r32, cb));
    bf16x8 q;
    if (d0 < QREG) q = qr[d0]; else q = *reinterpret_cast<const bf16x8*>(ql + (d0 - QREG) * 1024);
    p0 = __builtin_amdgcn_mfma_f32_32x32x16_bf16(b0, q, p0, 0, 0, 0);
    p1 = __builtin_amdgcn_mfma_f32_32x32x16_bf16(b1, q, p1, 0, 0, 0); }
}
__device__ __forceinline__ int v_st(int k, int c) { const int kk = (k & ~0xC) | ((k & 4) << 1) | ((k & 8) >> 1); return ((kk >> 3) * 4 + (c >> 5)) * 512 + ((kk & 7) * 32 + (c & 31)) * 2; }
__device__ __forceinline__ int v_rd_base(int lane) { return ((lane & 3) << 3) | (((lane >> 2) & 3) << 6) | (((lane >> 4) & 1) << 5) | (((lane >> 5) & 1) << 8); }
constexpr int v_rd_off(int d0, int ks, int half) { return d0 * 512 + ks * 4096 + half * 2048; }
template <int OFF> __device__ __forceinline__ s16x4 tr_read(int vb) {
  s16x4 r; asm volatile("ds_read_b64_tr_b16 %0, %1 offset:%2" : "=&v"(r) : "v"(vb), "i"(OFF) : "memory"); return r;
}
template <int D0> __device__ __forceinline__ void pv_one(f32x16& od, int vb, bf16x8 pa0, bf16x8 pa1, bf16x8 pa2, bf16x8 pa3) {
  const s16x4 l0 = tr_read<v_rd_off(D0, 0, 0)>(vb), h0 = tr_read<v_rd_off(D0, 0, 1)>(vb), l1 = tr_read<v_rd_off(D0, 1, 0)>(vb), h1 = tr_read<v_rd_off(D0, 1, 1)>(vb);
  const s16x4 l2 = tr_read<v_rd_off(D0, 2, 0)>(vb), h2 = tr_read<v_rd_off(D0, 2, 1)>(vb), l3 = tr_read<v_rd_off(D0, 3, 0)>(vb), h3 = tr_read<v_rd_off(D0, 3, 1)>(vb);
  asm volatile("s_waitcnt lgkmcnt(0)" ::: "memory"); SBAR();
#define PK(L, H) (bf16x8){L[0], L[1], L[2], L[3], H[0], H[1], H[2], H[3]}
  od = __builtin_amdgcn_mfma_f32_32x32x16_bf16(pa0, PK(l0, h0), od, 0, 0, 0);
  od = __builtin_amdgcn_mfma_f32_32x32x16_bf16(pa1, PK(l1, h1), od, 0, 0, 0);
  od = __builtin_amdgcn_mfma_f32_32x32x16_bf16(pa2, PK(l2, h2), od, 0, 0, 0);
  od = __builtin_amdgcn_mfma_f32_32x32x16_bf16(pa3, PK(l3, h3), od, 0, 0, 0);
#undef PK
}
__device__ __forceinline__ void pv_d0(f32x16* o, int vb, bf16x8 pa0, bf16x8 pa1, bf16x8 pa2, bf16x8 pa3) {
  pv_one<0>(o[0], vb, pa0, pa1, pa2, pa3); pv_one<1>(o[1], vb, pa0, pa1, pa2, pa3); pv_one<2>(o[2], vb, pa0, pa1, pa2, pa3); pv_one<3>(o[3], vb, pa0, pa1, pa2, pa3);
}

__device__ __forceinline__ void attn_unit(const bf16_t* __restrict__ Qg, const bf16_t* __restrict__ Kg, const bf16_t* __restrict__ Vg, bf16_t* __restrict__ Og,
                                          int qrow0, int h, int NT, int nctx_t, int kc0, int kl0, char* lds, const float* gq, const float* ropetab, bool lat) {
  int tid = threadIdx.x; asm volatile("" : "+v"(tid));
  const int wid = tid >> 6, lane = tid & 63, r32 = lane & 31, hi = lane >> 5;
  char* V_lds = lds; char* K_lds = lds + 2 * SHM_V;
  float* ws = (float*)(lds + 2 * SHM_V + 2 * SHM_K) + wid * 64; float* li_l = ws; float* al_l = ws + 32;
  float m_reg = -1e30f, l_reg = 0; f32x16 o[4] = {}; bf16x8 qr[QREG];
  char* ql = lds + SHM_QOFF + wid * ((12 - QREG) * 1024) + lane * 16;
  const ATT_GAS bf16_t* Qw = (const ATT_GAS bf16_t*)(Qg + (size_t)(qrow0 + wid * QBLK + r32) * LDQ + h * DQK + hi * 8);
  { u32x4 qraw[12];
#pragma unroll
    for (int d0 = 0; d0 < 12; ++d0) qraw[d0] = *(const ATT_GAS u32x4*)(Qw + d0 * 16);
    float ss = 0.f;
#pragma unroll
    for (int d0 = 0; d0 < 12; ++d0) { const u32x4 w = qraw[d0];
#pragma unroll
      for (int i = 0; i < 4; ++i) { const float lo = __builtin_bit_cast(float, w[i] << 16), hi_ = __builtin_bit_cast(float, w[i] & 0xffff0000u); ss += lo * lo + hi_ * hi_; } }
    { auto rr = __builtin_amdgcn_permlane32_swap(__float_as_uint(ss), __float_as_uint(ss), false, false); ss = __uint_as_float(rr[0]) + __uint_as_float(rr[1]); }
    const float rq = rsqrtf(ss * (1.0f / 192.0f) + 1e-6f) * QSCALE;
    const ATT_GAS float* gp = (const ATT_GAS float*)gq + hi * 8;
    const int tpos = (qrow0 + wid * QBLK + r32) & 2047;
#define QUNPK(W, X) do { _Pragma("unroll") for (int i_ = 0; i_ < 4; ++i_) { X[2 * i_] = __builtin_bit_cast(float, W[i_] << 16); X[2 * i_ + 1] = __builtin_bit_cast(float, W[i_] & 0xffff0000u); } } while (0)
#define QPUT(D0, Y) do { u32x4 w_ = {cvtpk(Y[0], Y[1]), cvtpk(Y[2], Y[3]), cvtpk(Y[4], Y[5]), cvtpk(Y[6], Y[7])}; const bf16x8 f_ = __builtin_bit_cast(bf16x8, w_); \
      if ((D0) < QREG) qr[(D0) < QREG ? (D0) : 0] = f_; else *reinterpret_cast<bf16x8*>(ql + ((D0) - QREG) * 1024) = f_; } while (0)
#pragma unroll
    for (int d0 = 0; d0 < 8; ++d0) { float x[8]; QUNPK(qraw[d0], x); const f32x4_ g0 = *(const ATT_GAS f32x4_*)(gp + d0 * 16), g1 = *(const ATT_GAS f32x4_*)(gp + d0 * 16 + 4);
#pragma unroll
      for (int i = 0; i < 4; ++i) { x[i] = x[i] * rq * g0[i]; x[4 + i] = x[4 + i] * rq * g1[i]; }
      QPUT(d0, x); }
#pragma unroll
    for (int ax = 0; ax < 2; ++ax) { float x1[8], x2[8]; QUNPK(qraw[8 + 2 * ax], x1); QUNPK(qraw[9 + 2 * ax], x2);
      const f32x4_ ga0 = *(const ATT_GAS f32x4_*)(gp + (8 + 2 * ax) * 16), ga1 = *(const ATT_GAS f32x4_*)(gp + (8 + 2 * ax) * 16 + 4), gb0 = *(const ATT_GAS f32x4_*)(gp + (9 + 2 * ax) * 16), gb1 = *(const ATT_GAS f32x4_*)(gp + (9 + 2 * ax) * 16 + 4);
      const ATT_GAS float* ct = (const ATT_GAS float*)ropetab + ((size_t)tpos * 2 + ax) * 16 + hi * 8;
      const f32x4_ c0 = *(const ATT_GAS f32x4_*)ct, c1 = *(const ATT_GAS f32x4_*)(ct + 4), s0 = *(const ATT_GAS f32x4_*)(ct + 2048 * 32), s1 = *(const ATT_GAS f32x4_*)(ct + 2048 * 32 + 4);
#pragma unroll
      for (int i = 0; i < 8; ++i) { const float g1_ = i < 4 ? ga0[i & 3] : ga1[i & 3], g2_ = i < 4 ? gb0[i & 3] : gb1[i & 3], c = i < 4 ? c0[i & 3] : c1[i & 3], s = i < 4 ? s0[i & 3] : s1[i & 3];
        const float y1 = x1[i] * rq * g1_, y2 = x2[i] * rq * g2_; x1[i] = lat ? (y1 * c - y2 * s) : y1; x2[i] = lat ? (y1 * s + y2 * c) : y2; }
      QPUT(8 + 2 * ax, x1); QPUT(9 + 2 * ax, x2); }
#undef QUNPK
#undef QPUT
  }
  const int sr = tid >> 4, sc = (tid & 15) * 8, vst0 = v_st(sr, sc), vst1 = v_st(32 + sr, sc);
  const int kr0 = tid / 24, kc0_ = (tid % 24) * 8, kr1 = (tid + 512) / 24, kc1_ = ((tid + 512) % 24) * 8, kr2 = (tid + 1024) / 24, kc2_ = ((tid + 1024) % 24) * 8;
  const int kst0 = KSWZ(kr0, kc0_ * 2), kst1 = KSWZ(kr1, kc1_ * 2), kst2 = KSWZ(kr2, kc2_ * 2);
  const int vb0 = (int)(uintptr_t)V_lds + v_rd_base(lane);
  const ATT_GAS bf16_t* Kh = (const ATT_GAS bf16_t*)(Kg + h * DQK); const ATT_GAS bf16_t* Vh = (const ATT_GAS bf16_t*)(Vg + h * DV);
  bf16x8 vs0, vs1, ks0, ks1, ks2;
#define KROW(t) ((t) < nctx_t ? kc0 + 64 * (t) : kl0 + 64 * ((t) - nctx_t))
#define SLOAD(t) do { const size_t k0_ = (size_t)KROW(t); \
    vs0 = *(const ATT_GAS bf16x8*)(&Vh[(k0_ + sr) * LDV + sc]); vs1 = *(const ATT_GAS bf16x8*)(&Vh[(k0_ + 32 + sr) * LDV + sc]); \
    ks0 = *(const ATT_GAS bf16x8*)(&Kh[(k0_ + kr0) * LDKK + kc0_]); ks1 = *(const ATT_GAS bf16x8*)(&Kh[(k0_ + kr1) * LDKK + kc1_]); \
    ks2 = *(const ATT_GAS bf16x8*)(&Kh[(k0_ + kr2) * LDKK + kc2_]); } while (0)
#define SWRITE(b) do { *(bf16x8*)(V_lds + (b) * SHM_V + vst0) = vs0; *(bf16x8*)(V_lds + (b) * SHM_V + vst1) = vs1; \
    *(bf16x8*)(K_lds + (b) * SHM_K + kst0) = ks0; *(bf16x8*)(K_lds + (b) * SHM_K + kst1) = ks1; *(bf16x8*)(K_lds + (b) * SHM_K + kst2) = ks2; } while (0)
#define SWAIT() asm volatile("s_waitcnt vmcnt(0)" ::: "memory")
#define RESC(a) do { if (__any((a) < 1.f)) { if (hi == 0) al_l[r32] = (a); asm volatile("s_waitcnt lgkmcnt(0)" ::: "memory"); \
    _Pragma("unroll") for (int d = 0; d < 4; ++d) _Pragma("unroll") for (int r = 0; r < 16; ++r) o[d][r] *= al_l[crow(r, hi)]; } } while (0)
  f32x16 pA0, pA1, pB0, pB1; float mnA, mnB, alA, alB; bf16x8 pa0, pa1, pa2, pa3;
  SLOAD(0); SWAIT(); SWRITE(0); __syncthreads();
  qkt(pA0, pA1, K_lds, qr, ql, r32, hi); partialSM(pA0, pA1, m_reg, mnA, alA);
  SLOAD(1);
  SWAIT(); SWRITE(1); __syncthreads();
  for (int j = 1; j + 1 < NT; j += 2) {
    SBAR(); qkt(pB0, pB1, K_lds + SHM_K, qr, ql, r32, hi);
    finishSM(pA0, pA1, alA, l_reg, pa0, pa1, pa2, pa3); SBAR();
    SLOAD(j + 1); SBAR();
    pv_d0(o, vb0, pa0, pa1, pa2, pa3); partialSM(pB0, pB1, m_reg, mnB, alB);
    __syncthreads(); SWAIT(); SWRITE(0);
    RESC(alB); __syncthreads();
    SBAR(); qkt(pA0, pA1, K_lds, qr, ql, r32, hi);
    finishSM(pB0, pB1, alB, l_reg, pa0, pa1, pa2, pa3); SBAR();
    SLOAD(j + 2); SBAR();
    pv_d0(o, vb0 + SHM_V, pa0, pa1, pa2, pa3); partialSM(pA0, pA1, m_reg, mnA, alA);
    __syncthreads(); SWAIT(); SWRITE(1);
    RESC(alA); __syncthreads();
  }
  SBAR(); qkt(pB0, pB1, K_lds + SHM_K, qr, ql, r32, hi);
  finishSM(pA0, pA1, alA, l_reg, pa0, pa1, pa2, pa3); SBAR();
  pv_d0(o, vb0, pa0, pa1, pa2, pa3); partialSM(pB0, pB1, m_reg, mnB, alB);
  __syncthreads(); RESC(alB);
  finishSM(pB0, pB1, alB, l_reg, pa0, pa1, pa2, pa3); SBAR();
  pv_d0(o, vb0 + SHM_V, pa0, pa1, pa2, pa3);
  if (hi == 0) li_l[r32] = l_reg; asm volatile("s_waitcnt lgkmcnt(0)" ::: "memory");
  float rli[16];
#pragma unroll
  for (int r = 0; r < 16; ++r) rli[r] = __builtin_amdgcn_rcpf(li_l[crow(r, hi)]);
  ATT_GAS bf16_t* Ow = (ATT_GAS bf16_t*)(Og + (size_t)(qrow0 + wid * QBLK) * LDO + h * DQK);
#pragma unroll
  for (int r = 0; r < 16; ++r) { const int orow = crow(r, hi);
#pragma unroll
    for (int d0 = 0; d0 < 4; ++d0) { const unsigned w = cvtpk(o[d0][r] * rli[r], 0.f); Ow[(size_t)orow * LDO + d0 * 32 + r32] = (bf16_t)(w & 0xffffu); } }
  __syncthreads();
#undef KROW
#undef SLOAD
#undef SWRITE
#undef SWAIT
#undef RESC
}
#undef KSWZ
#undef SBAR
}

#define LAS __attribute__((address_space(3)))
#define GAS __attribute__((address_space(1)))
typedef unsigned short bf16;
typedef float f32x4 __attribute__((ext_vector_type(4)));
typedef unsigned u32x4 __attribute__((ext_vector_type(4)));
typedef unsigned u32x2 __attribute__((ext_vector_type(2)));

constexpr int D = 1024, NBATCH = 16, SEQ = 2048, CTXL = 256, DEPTH = 4;
constexpr int RL = NBATCH * SEQ, RC = NBATCH * CTXL, RT = RL + RC;
constexpr int DFF = 2816, NCOND = 17, MODW = 9 * D;
constexpr float EPS = 1e-6f;
constexpr float QSC = 0.07216878364870322f * 1.4426950408889634f;
constexpr int NWAVES = 8;
constexpr int LDS_BYTES = 147456;

enum { I_X = 0, I_C, I_CTX, I_CCTX, I_WMOD, I_BMOD, I_GNORM, I_W1, I_W3, I_W2, I_SCWIN, I_SCCONV, I_SCWOUT, I_WA, I_GQA, I_WUQ, I_GKVA, I_WUKV, I_GQ, I_GK, I_WO, N_IN };

constexpr size_t MiB = 1u << 20;
constexpr size_t OFF_MOD = 0;
constexpr size_t OFF_ROPE = 4 * MiB;
constexpr size_t OFF_STAT = 4 * MiB + 512 * 1024;
constexpr size_t OFF_CTL = 6 * MiB, CTL_BYTES = 65536;

constexpr size_t OFF_WUP = 8 * MiB;
constexpr size_t SZ_WUP = (size_t)5632 * 1024 * 2;
constexpr size_t OFF_WDN = 96 * MiB;
constexpr size_t SZ_WDN = (size_t)1024 * 2816 * 2;
constexpr size_t OFF_WIN = 140 * MiB;
constexpr size_t SZ_WIN = (size_t)3072 * 1024 * 2;
constexpr size_t OFF_WOUT = 152 * MiB;
constexpr size_t SZ_SQ = (size_t)1024 * 1024 * 2;
constexpr size_t OFF_WA = 156 * MiB;
constexpr size_t SZ_WA = (size_t)512 * 1024 * 2;
constexpr size_t OFF_WUQ = 158 * MiB;
constexpr size_t SZ_WUQ = (size_t)1536 * 256 * 2;
constexpr size_t OFF_WUKV = 160 * MiB;
constexpr size_t SZ_WUKV = (size_t)2048 * 128 * 2;
constexpr size_t OFF_WO = 160 * MiB + 2 * MiB;
constexpr size_t SZ_WO = (size_t)1024 * 1536 * 2;
constexpr size_t OFF_HCTX = 168 * MiB;
constexpr size_t OFF_NH = 184 * MiB;
constexpr size_t OFF_BIG = 256 * MiB;
constexpr size_t OFF_ACT = OFF_BIG;
constexpr size_t OFF_BB = OFF_BIG;
constexpr size_t OFF_VV = OFF_BIG + 72 * MiB;
constexpr size_t OFF_YY = OFF_BIG + 144 * MiB;
constexpr size_t OFF_CQKV = OFF_BIG;
constexpr size_t OFF_Q = OFF_BIG + 36 * MiB;
constexpr size_t OFF_K = OFF_BIG + 144 * MiB;
constexpr size_t OFF_V = OFF_BIG + 252 * MiB;
constexpr size_t OFF_BIAS = OFF_BIG + 324 * MiB;
constexpr size_t BIAS_UP = 0, BIAS_WIN = (size_t)8 * 17 * 5632, BIAS_WA = BIAS_WIN + (size_t)2 * 17 * 3072;
constexpr size_t OFF_SS = OFF_BIAS + 4 * MiB;
constexpr size_t WS_END = OFF_BIAS + 8 * MiB;

struct Params { const float* in[N_IN]; float* out; unsigned char* ws; int pad0, pad1; };
constexpr int MISC_OFF = LDS_BYTES - 512;
constexpr int PTAB_OFF = LDS_BYTES - 256, I_OUT = N_IN, I_WS = N_IN + 1;
__device__ __forceinline__ unsigned long long ldp_raw(int i) {
    volatile LAS unsigned* t = (volatile LAS unsigned*)(uintptr_t)PTAB_OFF;
    const unsigned lo = __builtin_amdgcn_readfirstlane(t[2 * i]), hi = __builtin_amdgcn_readfirstlane(t[2 * i + 1]);
    return ((unsigned long long)hi << 32) | lo;
}
__device__ __forceinline__ const float* ldp(int i) { return (const float*)ldp_raw(i); }
__device__ __forceinline__ unsigned char* ldws() { return (unsigned char*)ldp_raw(I_WS); }

__device__ __forceinline__ float wave_sum(float v) {
#pragma unroll
    for (int o = 1; o < 64; o <<= 1) v += __shfl_xor(v, o);
    return v;
}
__device__ __forceinline__ float wave_sum_dpp(float v) {
    v += __builtin_bit_cast(float, __builtin_amdgcn_mov_dpp(__builtin_bit_cast(int, v), 0xB1, 0xf, 0xf, false));
    v += __builtin_bit_cast(float, __builtin_amdgcn_mov_dpp(__builtin_bit_cast(int, v), 0x4E, 0xf, 0xf, false));
    v += __builtin_bit_cast(float, __builtin_amdgcn_mov_dpp(__builtin_bit_cast(int, v), 0x141, 0xf, 0xf, false));
    v += __builtin_bit_cast(float, __builtin_amdgcn_mov_dpp(__builtin_bit_cast(int, v), 0x140, 0xf, 0xf, false));
    return pg8::xrow_sum(v);
}
__device__ __forceinline__ unsigned f2bf(float f) { unsigned u = __builtin_bit_cast(unsigned, f); return (u + 0x7fffu + ((u >> 16) & 1u)) >> 16; }
__device__ __forceinline__ unsigned pk2(float lo, float hi) { unsigned r; asm("v_cvt_pk_bf16_f32 %0, %1, %2" : "=v"(r) : "v"(lo), "v"(hi)); return r; }
__device__ __forceinline__ float bf_lo(unsigned w) { return __builtin_bit_cast(float, w << 16); }
__device__ __forceinline__ float bf_hi(unsigned w) { return __builtin_bit_cast(float, w & 0xffff0000u); }

__device__ __forceinline__ void transpose_item(const float* W, int K, int N, bf16* WT, int Kd, int mode, const float* kscale, LAS float* scr, int item, int lane) {
    const int nblk = N / 32, kb = item / nblk, nb = item % nblk, k0 = 64 * kb, n0 = 32 * nb;
    float tv[32];
#pragma unroll
    for (int i = 0; i < 32; ++i) { const int kk = 2 * i + (lane >> 5); tv[i] = W[(size_t)(k0 + kk) * N + n0 + (lane & 31)]; }
#pragma unroll
    for (int i = 0; i < 32; ++i) { const int kk = 2 * i + (lane >> 5); scr[kk * 33 + (lane & 31)] = tv[i]; }
    asm volatile("s_waitcnt lgkmcnt(0)" ::: "memory");
    int r0;
    if (mode == 0) r0 = n0;
    else if (mode == 1) r0 = 256 * (n0 >> 7) + (n0 & 127);
    else if (mode == 2) r0 = 256 * (n0 >> 7) + 128 + (n0 & 127);
    else { if (n0 < 1024) r0 = n0; else if (n0 < 2048) { const int c = n0 - 1024; r0 = 1024 + 256 * (c >> 7) + (c & 127); } else { const int c = n0 - 2048; r0 = 1024 + 256 * (c >> 7) + 128 + (c & 127); } }
    const int c = lane & 7; const int kd0 = (mode == 4) ? 192 * (k0 >> 7) + (k0 & 127) : k0;
    float ks[8];
#pragma unroll
    for (int q = 0; q < 8; ++q) ks[q] = kscale ? kscale[k0 + 8 * c + q] : 1.0f;
#pragma unroll
    for (int j = 0; j < 4; ++j) { const int n = (lane >> 3) + 8 * j; const LAS float* s = scr + (8 * c) * 33 + n;
        u32x4 o; o.x = pk2(s[0 * 33] * ks[0], s[1 * 33] * ks[1]); o.y = pk2(s[2 * 33] * ks[2], s[3 * 33] * ks[3]); o.z = pk2(s[4 * 33] * ks[4], s[5 * 33] * ks[5]); o.w = pk2(s[6 * 33] * ks[6], s[7 * 33] * ks[7]);
        *(u32x4*)(WT + (size_t)(r0 + n) * Kd + kd0 + 8 * c) = o; }
    asm volatile("s_waitcnt lgkmcnt(0)" ::: "memory");
}

constexpr int IT_FFN = 1408;
constexpr int IT_A0 = 0, IT_B0 = IT_A0 + 8 * IT_FFN, IT_C0 = IT_B0 + 8 * IT_FFN, IT_D0 = IT_C0 + 8 * IT_FFN;
constexpr int IT_WIN = 16 * 96, IT_SQ = 16 * 32, IT_WA = 16 * 14, IT_WUQ = 4 * 48, IT_WUKV = 2 * 64;
constexpr int IT_E0 = IT_D0 + 2 * IT_WIN, IT_F0 = IT_E0 + 2 * IT_SQ, IT_G0 = IT_F0 + 2 * IT_SQ, IT_H0 = IT_G0 + 2 * IT_WA, IT_I0 = IT_H0 + 2 * IT_WUQ, IT_END = IT_I0 + 2 * IT_WUKV;

__device__ __forceinline__ void convert_item(int it, LAS float* scr, int lane) {
    unsigned char* ws = ldws();
    if (it < IT_B0) { const int m = it / IT_FFN, r = it % IT_FFN; transpose_item(ldp(I_W1) + (size_t)m * D * DFF, D, DFF, (bf16*)(ws + OFF_WUP + m * SZ_WUP), D, 1, nullptr, scr, r, lane); return; }
    if (it < IT_C0) { it -= IT_B0; const int m = it / IT_FFN, r = it % IT_FFN; transpose_item(ldp(I_W3) + (size_t)m * D * DFF, D, DFF, (bf16*)(ws + OFF_WUP + m * SZ_WUP), D, 2, nullptr, scr, r, lane); return; }
    if (it < IT_D0) { it -= IT_C0; const int m = it / IT_FFN, r = it % IT_FFN; transpose_item(ldp(I_W2) + (size_t)m * DFF * D, DFF, D, (bf16*)(ws + OFF_WDN + m * SZ_WDN), DFF, 0, nullptr, scr, r, lane); return; }
    if (it < IT_E0) { it -= IT_D0; const int m = it / IT_WIN, r = it % IT_WIN; transpose_item(ldp(I_SCWIN) + (size_t)m * D * 3072, D, 3072, (bf16*)(ws + OFF_WIN + m * SZ_WIN), D, 3, nullptr, scr, r, lane); return; }
    if (it < IT_F0) { it -= IT_E0; const int m = it / IT_SQ, r = it % IT_SQ; transpose_item(ldp(I_SCWOUT) + (size_t)m * D * D, D, D, (bf16*)(ws + OFF_WOUT + m * SZ_SQ), D, 0, nullptr, scr, r, lane); return; }
    if (it < IT_G0) { it -= IT_F0; const int m = it / IT_SQ, r = it % IT_SQ; transpose_item(ldp(I_WO) + (size_t)m * D * D, D, D, (bf16*)(ws + OFF_WO + m * SZ_WO), 1536, 4, nullptr, scr, r, lane); return; }
    if (it < IT_H0) { it -= IT_G0; const int m = it / IT_WA, r = it % IT_WA; transpose_item(ldp(I_WA) + (size_t)m * D * 448, D, 448, (bf16*)(ws + OFF_WA + m * SZ_WA), D, 0, nullptr, scr, r, lane); return; }
    if (it < IT_I0) { it -= IT_H0; const int m = it / IT_WUQ, r = it % IT_WUQ; transpose_item(ldp(I_WUQ) + (size_t)m * 256 * 1536, 256, 1536, (bf16*)(ws + OFF_WUQ + m * SZ_WUQ), 256, 0, ldp(I_GQA) + m * 256, scr, r, lane); return; }
    { it -= IT_I0; const int m = it / IT_WUKV, r = it % IT_WUKV; transpose_item(ldp(I_WUKV) + (size_t)m * 128 * 2048, 128, 2048, (bf16*)(ws + OFF_WUKV + m * SZ_WUKV), 128, 0, ldp(I_GKVA) + m * 128, scr, r, lane); }
}

__device__ __forceinline__ void mod_group(int grp, LAS unsigned char* lds, int tid, int wave, int lane) {
    LAS float* S = (LAS float*)lds;
    const float* cin = ldp(I_C); const float* cctx = ldp(I_CCTX);
    for (int i = tid; i < NCOND * 1024; i += 512) { const int c = i >> 10, k = i & 1023; const float v = c < 16 ? cin[c * 1024 + k] : cctx[k]; S[i] = v / (1.0f + __expf(-v)); }
    __syncthreads();
    const int l = grp / 36, cg0 = (grp % 36) * 256;
    const float* W = ldp(I_WMOD) + (size_t)l * 1024 * MODW + cg0 + lane * 4;
    const int kbase = wave * 128;
    f32x4 acc[NCOND];
#pragma unroll
    for (int c = 0; c < NCOND; ++c) acc[c] = (f32x4){0.f, 0.f, 0.f, 0.f};
    for (int kk = 0; kk < 128; kk += 4) {
        const float* wp = W + (size_t)(kbase + kk) * MODW;
        const f32x4 w0 = *(const f32x4*)(wp), w1 = *(const f32x4*)(wp + MODW), w2 = *(const f32x4*)(wp + 2 * MODW), w3 = *(const f32x4*)(wp + 3 * MODW);
#pragma unroll
        for (int c = 0; c < NCOND; ++c) { const f32x4 s = *(const LAS f32x4*)(S + c * 1024 + kbase + kk); acc[c] += w0 * s.x + w1 * s.y + w2 * s.z + w3 * s.w; }
    }
    __syncthreads();
    LAS float* P = (LAS float*)lds;
#pragma unroll
    for (int c = 0; c < NCOND; ++c) *(LAS f32x4*)(P + (wave * NCOND + c) * 256 + lane * 4) = acc[c];
    __syncthreads();
    float* MOD = (float*)(ldws() + OFF_MOD); const float* bmod = ldp(I_BMOD);
    for (int o = tid; o < NCOND * 256; o += 512) { const int c = o >> 8, col = o & 255; float s = bmod[l * MODW + cg0 + col];
#pragma unroll
        for (int w = 0; w < 8; ++w) s += P[(w * NCOND + c) * 256 + col];
        MOD[(size_t)(l * NCOND + c) * MODW + cg0 + col] = s; }
    __syncthreads();
}

__device__ __forceinline__ void norm_phase(const float* hl, const float* hc, const float* g, const float* modl, int chunk, bf16* NH, int nrows, int gw, int NGW, int lane) {
    for (int row = gw; row < nrows; row += NGW) {
        const float* src = row < RL ? hl + (size_t)row * D : hc + (size_t)(row - RL) * D;
        const int cond = row < RL ? (row >> 11) : 16;
        const float* sh = modl + (size_t)cond * MODW + chunk * D; const float* sc = sh + D;
        f32x4 v[4]; float s = 0.f;
#pragma unroll
        for (int j = 0; j < 4; ++j) { v[j] = ((const f32x4*)src)[lane + 64 * j]; s += (v[j].x * v[j].x + v[j].y * v[j].y) + (v[j].z * v[j].z + v[j].w * v[j].w); }
        const float rstd = rsqrtf(wave_sum(s) * (1.0f / D) + EPS);
        u32x2* o8 = (u32x2*)(NH + (size_t)row * D) + lane;
#pragma unroll
        for (int j = 0; j < 4; ++j) { const f32x4 gg = ((const f32x4*)g)[lane + 64 * j], ss = ((const f32x4*)sc)[lane + 64 * j], hh = ((const f32x4*)sh)[lane + 64 * j];
            const f32x4 y = v[j] * rstd * gg * (ss + 1.0f) + hh; u32x2 w; w.x = pk2(y.x, y.y); w.y = pk2(y.z, y.w); o8[64 * j] = w; }
    }
}


__device__ __forceinline__ void bias_unit(int unit, LAS unsigned char* lds, int tid, int wave, int lane) {
    unsigned char* ws = ldws(); const float* MOD = (const float*)(ws + OFF_MOD); float* BIAS = (float*)(ws + OFF_BIAS);
    int l, chunk, N, row0; const bf16* Bt; float* out;
    if (unit < 352) { const int m = unit / 44; l = m >> 1; chunk = (m & 1) ? 6 : 0; N = 5632; row0 = (unit % 44) * 128; Bt = (const bf16*)(ws + OFF_WUP + m * SZ_WUP); out = BIAS + BIAS_UP + (size_t)m * 17 * 5632; }
    else if (unit < 400) { const int j = (unit - 352) / 24; l = 2 * j; chunk = 3; N = 3072; row0 = ((unit - 352) % 24) * 128; Bt = (const bf16*)(ws + OFF_WIN + j * SZ_WIN); out = BIAS + BIAS_WIN + (size_t)j * 17 * 3072; }
    else { const int j = (unit - 400) / 4; l = 2 * j + 1; chunk = 3; N = 512; row0 = ((unit - 400) % 4) * 128; Bt = (const bf16*)(ws + OFF_WA + j * SZ_WA); out = BIAS + BIAS_WA + (size_t)j * 17 * 512; }
    LAS float* S = (LAS float*)lds;
    __syncthreads();
    for (int i = tid * 4; i < NCOND * 1024; i += 2048) { const int c = i >> 10, k = i & 1023; *(LAS f32x4*)(S + i) = *(const GAS f32x4*)(MOD + (size_t)(l * NCOND + c) * MODW + chunk * D + k); }
    __syncthreads();
    for (int r = 0; r < 16; ++r) { const int n = row0 + wave * 16 + r;
        float w[16];
#pragma unroll
        for (int q = 0; q < 4; ++q) { const u32x2 v = *(const u32x2*)(Bt + (size_t)n * D + 256 * q + 4 * lane); w[4 * q] = bf_lo(v.x); w[4 * q + 1] = bf_hi(v.x); w[4 * q + 2] = bf_lo(v.y); w[4 * q + 3] = bf_hi(v.y); }
        float mine = 0.f;
#pragma unroll
        for (int c = 0; c < NCOND; ++c) { float a = 0.f;
#pragma unroll
            for (int q = 0; q < 4; ++q) { const f32x4 sv = *(const LAS f32x4*)(S + c * 1024 + 256 * q + 4 * lane); a += sv.x * w[4 * q] + sv.y * w[4 * q + 1] + sv.z * w[4 * q + 2] + sv.w * w[4 * q + 3]; }
            a = wave_sum_dpp(a); mine = (lane == c) ? a : mine; }
        if (lane < NCOND) out[(size_t)lane * N + n] = mine;
    }
}
__device__ __forceinline__ void first_aprime(const float* xl, const float* xc, const float* g, const float* sc0, bf16* NH, float* SS, int gw, int NGW, int lane) {
    for (int row0 = gw; row0 < RT; row0 += 4 * NGW) {
        f32x4 v[4][4];
#pragma unroll
        for (int q = 0; q < 4; ++q) { const int row = (row0 + q * NGW < RT) ? row0 + q * NGW : row0; const float* src = row < RL ? xl + (size_t)row * D : xc + (size_t)(row - RL) * D;
#pragma unroll
            for (int j = 0; j < 4; ++j) v[q][j] = ((const f32x4*)src)[lane + 64 * j]; }
#pragma unroll
        for (int q = 0; q < 4; ++q) { const int row = row0 + q * NGW; if (row < RT) {
            const int cond = row < RL ? (row >> 11) : 16; const float* sc = sc0 + (size_t)cond * MODW; float s = 0.f;
#pragma unroll
            for (int j = 0; j < 4; ++j) s += (v[q][j].x * v[q][j].x + v[q][j].y * v[q][j].y) + (v[q][j].z * v[q][j].z + v[q][j].w * v[q][j].w);
            s = wave_sum_dpp(s); if (lane < 16) SS[(size_t)row * 16 + lane] = (lane == 0) ? s : 0.f;
            u32x2* o8 = (u32x2*)(NH + (size_t)row * D) + lane;
#pragma unroll
            for (int j = 0; j < 4; ++j) { const f32x4 gg = ((const f32x4*)g)[lane + 64 * j], ss = ((const f32x4*)sc)[lane + 64 * j];
                const f32x4 y = v[q][j] * gg * (ss + 1.0f); u32x2 w; w.x = pk2(y.x, y.y); w.y = pk2(y.z, y.w); o8[64 * j] = w; } } }
    }
}


__device__ __forceinline__ void ctx_fix(const float* hin, float* hout, const float* part, const float* gate16, float gs, bf16* NHc, float* SSc_, const float* gn, const float* sc16, int gw, int NGW, int lane) {
    for (int r = gw; r < RC; r += NGW) {
        const GAS f32x4* hp = (const GAS f32x4*)(hin + (size_t)r * D) + lane; GAS f32x4* op = (GAS f32x4*)(hout + (size_t)r * D) + lane;
        f32x4 h[4], p[4][4];
#pragma unroll
        for (int j = 0; j < 4; ++j) { h[j] = hp[64 * j];
#pragma unroll
            for (int q = 0; q < 4; ++q) { const u32x2 w_ = ((const GAS u32x2*)((const bf16*)part + ((size_t)q * RC + r) * D) + lane)[64 * j]; p[q][j] = (f32x4){bf_lo(w_.x), bf_hi(w_.x), bf_lo(w_.y), bf_hi(w_.y)}; } }
        float sq = 0.f; f32x4 o[4];
#pragma unroll
        for (int j = 0; j < 4; ++j) { const f32x4 gg = ((const f32x4*)gate16)[lane + 64 * j] * gs; o[j] = h[j] + gg * (((p[0][j] + p[1][j]) + p[2][j]) + p[3][j]); op[64 * j] = o[j];
            sq += (o[j].x * o[j].x + o[j].y * o[j].y) + (o[j].z * o[j].z + o[j].w * o[j].w); }
        if (gn) {
            sq = wave_sum_dpp(sq); if (lane < 16) SSc_[(size_t)(RL + r) * 16 + lane] = (lane == 0) ? sq : 0.f;
            GAS u32x2* a8 = (GAS u32x2*)(NHc + (size_t)(RL + r) * D) + lane;
#pragma unroll
            for (int j = 0; j < 4; ++j) { const f32x4 y = o[j] * ((const f32x4*)gn)[lane + 64 * j] * (((const f32x4*)sc16)[lane + 64 * j] + 1.0f); u32x2 w; w.x = pk2(y.x, y.y); w.y = pk2(y.z, y.w); a8[64 * j] = w; }
        }
    }
}

__device__ __forceinline__ void stats_phase(const bf16* CQKV, float* rq, float* rkv, int gw, int NGW, int lane) {
    for (int row = gw; row < RT; row += NGW) {
        const u32x2 a = *((const u32x2*)(CQKV + (size_t)row * 512) + lane);
        float sq = bf_lo(a.x) * bf_lo(a.x) + bf_hi(a.x) * bf_hi(a.x) + bf_lo(a.y) * bf_lo(a.y) + bf_hi(a.y) * bf_hi(a.y);
        float sk = 0.f;
        if (lane < 32) { const u32x2 b = *((const u32x2*)(CQKV + (size_t)row * 512 + 256) + lane); sk = bf_lo(b.x) * bf_lo(b.x) + bf_hi(b.x) * bf_hi(b.x) + bf_lo(b.y) * bf_lo(b.y) + bf_hi(b.y) * bf_hi(b.y); }
        sq = wave_sum_dpp(sq); sk = wave_sum(sk);
        if (lane == 0) { rq[row] = rsqrtf(sq * (1.0f / 256.0f) + EPS); rkv[row] = rsqrtf(sk * (1.0f / 128.0f) + EPS); }
    }
}

__device__ __forceinline__ void unpack8(const u32x4 w, float* x) { x[0] = bf_lo(w.x); x[1] = bf_hi(w.x); x[2] = bf_lo(w.y); x[3] = bf_hi(w.y); x[4] = bf_lo(w.z); x[5] = bf_hi(w.z); x[6] = bf_lo(w.w); x[7] = bf_hi(w.w); }
__device__ __forceinline__ float dpp_xor1(float v) { return __builtin_bit_cast(float, __builtin_amdgcn_mov_dpp(__builtin_bit_cast(int, v), 0xB1, 0xf, 0xf, false)); }
__device__ __forceinline__ float dpp_xor2(float v) { return __builtin_bit_cast(float, __builtin_amdgcn_mov_dpp(__builtin_bit_cast(int, v), 0x4E, 0xf, 0xf, false)); }
__device__ __forceinline__ float dpp_hmirror(float v) { return __builtin_bit_cast(float, __builtin_amdgcn_mov_dpp(__builtin_bit_cast(int, v), 0x141, 0xf, 0xf, false)); }
__device__ __forceinline__ void qk_fin8(const u32x4 (&w)[3], const float (&g)[3][8], const float* cs, const float* sn, bool rope, bool second, float outscale, u32x4 (&o)[3]) {
    float x[3][8]; float ss = 0.f;
#pragma unroll
    for (int j = 0; j < 3; ++j) { unpack8(w[j], x[j]);
#pragma unroll
        for (int i = 0; i < 8; ++i) ss += x[j][i] * x[j][i]; }
    ss += dpp_xor1(ss); ss += dpp_xor2(ss); ss += dpp_hmirror(ss);
    const float r = rsqrtf(ss * (1.0f / 192.0f) + EPS);
#pragma unroll
    for (int j = 0; j < 3; ++j)
#pragma unroll
        for (int i = 0; i < 8; ++i) x[j][i] = x[j][i] * r * g[j][i];
    float pr[8];
#pragma unroll
    for (int i = 0; i < 8; ++i) pr[i] = dpp_xor2(x[2][i]);
    if (rope) {
#pragma unroll
        for (int i = 0; i < 8; ++i) x[2][i] = second ? (pr[i] * sn[i] + x[2][i] * cs[i]) : (x[2][i] * cs[i] - pr[i] * sn[i]);
    }
#pragma unroll
    for (int j = 0; j < 3; ++j) { o[j].x = pk2(x[j][0] * outscale, x[j][1] * outscale); o[j].y = pk2(x[j][2] * outscale, x[j][3] * outscale); o[j].z = pk2(x[j][4] * outscale, x[j][5] * outscale); o[j].w = pk2(x[j][6] * outscale, x[j][7] * outscale); }
}
__device__ __forceinline__ void finalize_phase(bf16* Qb_, bf16* Kb_, const bf16* CQKV_, const float* gq, const float* gk, const float* ropetab, bool need_qc, int gw, int NGW, int lane) {
    GAS bf16* Kb = (GAS bf16*)Kb_; const GAS bf16* CQKV = (const GAS bf16*)CQKV_; const GAS float* rt = (const GAS float*)ropetab;
    const int l8 = lane & 7, head = lane >> 3;
    float gkv[3][8];
#pragma unroll
    for (int j = 0; j < 3; ++j)
#pragma unroll
        for (int i = 0; i < 8; ++i) gkv[j][i] = gk[(l8 + 8 * j) * 8 + i];
    const int axis = (l8 >= 4) ? 1 : 0, f0 = 8 * (l8 & 1); const bool second = (l8 & 2) != 0;
    for (int row0 = gw; row0 < RT; row0 += 4 * NGW) {
        u32x4 kw[4][3]; f32x4 cc[4][4];
#pragma unroll
        for (int q = 0; q < 4; ++q) { const int row = (row0 + q * NGW < RT) ? row0 + q * NGW : row0; const int t = row < RL ? (row & (SEQ - 1)) : 0;
            const GAS float* ct = rt + ((size_t)t * 2 + axis) * 16 + f0; const size_t o0 = (size_t)row * 1536 + head * 192 + l8 * 8;
            cc[q][0] = *(const GAS f32x4*)ct; cc[q][1] = *(const GAS f32x4*)(ct + 4); cc[q][2] = *(const GAS f32x4*)(ct + SEQ * 32); cc[q][3] = *(const GAS f32x4*)(ct + SEQ * 32 + 4);
            kw[q][0] = *(const GAS u32x4*)(Kb + o0); kw[q][1] = *(const GAS u32x4*)(Kb + o0 + 64); kw[q][2] = *(const GAS u32x4*)(CQKV + (size_t)row * 512 + 384 + l8 * 8); }
#pragma unroll
        for (int q = 0; q < 4; ++q) { const int row = row0 + q * NGW; if (row < RT) {
            const float cs[8] = {cc[q][0].x, cc[q][0].y, cc[q][0].z, cc[q][0].w, cc[q][1].x, cc[q][1].y, cc[q][1].z, cc[q][1].w}, sn[8] = {cc[q][2].x, cc[q][2].y, cc[q][2].z, cc[q][2].w, cc[q][3].x, cc[q][3].y, cc[q][3].z, cc[q][3].w};
            u32x4 ov[3]; qk_fin8(kw[q], gkv, cs, sn, row < RL, second, 1.0f, ov);
            const size_t o0 = (size_t)row * 1536 + head * 192 + l8 * 8;
#pragma unroll
            for (int j = 0; j < 3; ++j) *(GAS u32x4*)(Kb + o0 + 64 * j) = ov[j]; } }
    }
}

__device__ __forceinline__ void conv_phase(const bf16* Bb_, const bf16* Vb_, const float* cw, bf16* Y_, int gtid, int NT_) {
    const GAS bf16* Bb = (const GAS bf16*)Bb_; const GAS bf16* Vb = (const GAS bf16*)Vb_; GAS bf16* Y = (GAS bf16*)Y_;
    const int c8 = (gtid & 127) * 8;
    float w0[8], w1[8], w2[8];
#pragma unroll
    for (int i = 0; i < 8; ++i) { w0[i] = cw[c8 + i]; w1[i] = cw[D + c8 + i]; w2[i] = cw[2 * D + c8 + i]; }
    for (int it0 = gtid; it0 < RT * 128; it0 += 4 * NT_) {
        u32x4 lb[4], l0[4], l1[4], l2[4]; float m0[4], m2[4];
#pragma unroll
        for (int q = 0; q < 4; ++q) { const int it = (it0 + q * NT_ < RT * 128) ? it0 + q * NT_ : it0;
            const int row = it >> 7;
            const int pos = row < RL ? (row & (SEQ - 1)) : ((row - RL) & (CTXL - 1)); const int len = row < RL ? SEQ : CTXL;
            const size_t off = (size_t)row * D + c8; const bool hp = pos > 0, hn = pos < len - 1;
            lb[q] = *(const GAS u32x4*)(Bb + off); l1[q] = *(const GAS u32x4*)(Vb + off);
            l0[q] = *(const GAS u32x4*)(Vb + (hp ? off - D : off)); l2[q] = *(const GAS u32x4*)(Vb + (hn ? off + D : off));
            m0[q] = hp ? 1.f : 0.f; m2[q] = hn ? 1.f : 0.f; }
#pragma unroll
        for (int q = 0; q < 4; ++q) { const int it = it0 + q * NT_; if (it < RT * 128) {
            const int row = it >> 7; const size_t off = (size_t)row * D + c8;
            float b[8], v0[8], v1[8], v2[8], y[8];
            unpack8(lb[q], b); unpack8(l0[q], v0); unpack8(l1[q], v1); unpack8(l2[q], v2);
#pragma unroll
            for (int i = 0; i < 8; ++i) y[i] = b[i] * (w0[i] * m0[q] * v0[i] + w1[i] * v1[i] + w2[i] * m2[q] * v2[i]);
            u32x4 o; o.x = pk2(y[0], y[1]); o.y = pk2(y[2], y[3]); o.z = pk2(y[4], y[5]); o.w = pk2(y[6], y[7]);
            *(GAS u32x4*)(Y + off) = o; } }
    }
}

#define XB_TMO      128
#define XB_XCNT(j)  (256  + 64 * (j))
#define XB_XSUB(j)  (1280 + 64 * (j))
#define XB_XGEN(j)  (2304 + 64 * (j))
#define XB_TOP      3328
#define XB_TOPGEN   3392
#define XCD_BAR_WORDS 3456
#define XB_SPIN_CAP (1u << 18)

__device__ __forceinline__ unsigned xb_ld(unsigned* p)              { return __hip_atomic_load(p, __ATOMIC_RELAXED, __HIP_MEMORY_SCOPE_AGENT); }
__device__ __forceinline__ unsigned xb_add(unsigned* p, unsigned v) { return __hip_atomic_fetch_add(p, v, __ATOMIC_RELAXED, __HIP_MEMORY_SCOPE_AGENT); }
__device__ __forceinline__ unsigned xb_xcc_id() { return (unsigned)__builtin_amdgcn_s_getreg((3 << 11) | 20) & 0xFu; }
#define XB_SPIN(cond, bar) do { unsigned _sp = 0; while (cond) { __builtin_amdgcn_s_sleep(1); \
    if ((++_sp & 255u) == 0u) { if (xb_ld(&(bar)[XB_TMO])) break; if (_sp > XB_SPIN_CAP) { atomicAdd(&(bar)[XB_TMO], 1u); break; } } } } while (0)

struct XcdBarrier {
    unsigned* bar; unsigned x;
    volatile LAS unsigned* st;
};

__device__ __forceinline__ XcdBarrier xcd_barrier_post(unsigned* bar, volatile LAS unsigned* st) {
    XcdBarrier b; b.bar = bar; b.x = xb_xcc_id(); b.st = st;
    if (threadIdx.x == 0) (void)xb_add(&bar[XB_XCNT(b.x)], 1u);
    return b;
}
__device__ __forceinline__ void xcd_barrier_complete(unsigned* bar, unsigned x, unsigned& nloc, unsigned& nx) {
    const unsigned G = gridDim.x * gridDim.y * gridDim.z;
    unsigned sum, cnt, mine, sp = 0u;
    for (;;) {
        sum = 0u; cnt = 0u; mine = 0u;
#pragma unroll
        for (unsigned j = 0; j < 16; ++j) { const unsigned c = xb_ld(&bar[XB_XCNT(j)]); sum += c; cnt += (c > 0u) ? 1u : 0u; mine = (j == x) ? c : mine; }
        if (sum == G) break;
        __builtin_amdgcn_s_sleep(1);
        if ((++sp & 255u) == 0u) { if (xb_ld(&bar[XB_TMO])) break; if (sp > XB_SPIN_CAP) { atomicAdd(&bar[XB_TMO], 1u); break; } }
    }
    nloc = mine > 0u ? mine : 1u; nx = cnt > 0u ? cnt : 1u;
}

__device__ __forceinline__ void xcd_barrier(const XcdBarrier& b) {
    asm volatile("s_waitcnt vmcnt(0)" ::: "memory");
    __syncthreads();
    if (threadIdx.x == 0) {
        unsigned* bar = b.bar;
        __builtin_amdgcn_s_waitcnt(0);
        unsigned nloc = b.st[0], nx = b.st[1];
        if (nloc == 0u) { xcd_barrier_complete(bar, b.x, nloc, nx); b.st[0] = nloc; b.st[1] = nx; }
        const unsigned old = xb_add(&bar[XB_XSUB(b.x)], 1u);
        const unsigned gen = old / nloc;
        if (old + 1u == (gen + 1u) * nloc) {
            __builtin_amdgcn_fence(__ATOMIC_RELEASE, "agent");
            asm volatile("s_waitcnt vmcnt(0)" ::: "memory");
            const unsigned og = xb_add(&bar[XB_TOP], 1u);
            const unsigned tg = og / nx;
            if (og + 1u == (tg + 1u) * nx) xb_add(&bar[XB_TOPGEN], 1u);
            else XB_SPIN(xb_ld(&bar[XB_TOPGEN]) == tg, bar);
            __builtin_amdgcn_fence(__ATOMIC_ACQUIRE, "agent");
            xb_add(&bar[XB_XGEN(b.x)], 1u);
            asm volatile("s_waitcnt vmcnt(0)" ::: "memory");
        } else {
            XB_SPIN(xb_ld(&bar[XB_XGEN(b.x)]) == gen, bar);
            __builtin_amdgcn_fence(__ATOMIC_ACQUIRE, "agent");
            asm volatile("s_waitcnt vmcnt(0)" ::: "memory");
        }
    }
    __syncthreads();
}


typedef pg8::GemmT<D, DFF, DFF> GemmDn; typedef pg8::GemmT<D, D, D> GemmSq; typedef pg8::GemmT<D, 1536, 1536> GemmWo;
#define GSYNC() do { XcdBarrier b_; b_.bar = (unsigned*)(ldws() + OFF_CTL); b_.x = xb_xcc_id(); b_.st = (volatile LAS unsigned*)(uintptr_t)MISC_OFF; xcd_barrier(b_); } while (0)
__global__ void __launch_bounds__(NWAVES * 64) fwd_megakernel(Params p) {
    extern __shared__ __attribute__((aligned(16))) unsigned char lds_raw[];
    cg::grid_group grid = cg::this_grid();
    LAS unsigned char* lds = (LAS unsigned char*)lds_raw;
    const int tid = threadIdx.x, lane = tid & 63, wave = __builtin_amdgcn_readfirstlane(tid >> 6);
    if (tid == 0) {
        volatile LAS unsigned long long* t = (volatile LAS unsigned long long*)(uintptr_t)PTAB_OFF;
#pragma unroll
        for (int i = 0; i < N_IN; ++i) t[i] = (unsigned long long)p.in[i];
        t[I_OUT] = (unsigned long long)p.out; t[I_WS] = (unsigned long long)p.ws;
        volatile LAS unsigned* m = (volatile LAS unsigned*)(uintptr_t)MISC_OFF; m[0] = 0u; m[1] = 0u;
    }
    __syncthreads();
    (void)xcd_barrier_post((unsigned*)(p.ws + OFF_CTL), (volatile LAS unsigned*)(uintptr_t)MISC_OFF);
    if (p.pad0 != 0) grid.sync();
#define BX() ({ int b_ = blockIdx.x; asm volatile("" : "+s"(b_)); b_; })
#define GD() ({ int g_ = gridDim.x; asm volatile("" : "+s"(g_)); g_; })
#define GW (BX() * NWAVES + wave)
#define NGW_ (GD() * NWAVES)

    {
        const int G = GD(), bx = BX();
#ifndef NO_MOD
        for (int g = bx; g < 144; g += G) mod_group(g, lds, tid, wave, lane);
#endif
        unsigned char* ws = ldws(); float* ROPE = (float*)(ws + OFF_ROPE);
        for (int i = bx * 512 + tid; i < SEQ * 32; i += G * 512) { const int t = i >> 5, axis = (i >> 4) & 1, f = i & 15; const float pos = (float)(axis ? (t & 63) : (t >> 6));
            const float inv = exp2f(-(float)f * (13.287712379549449f / 16.0f)); const float a = pos * inv; ROPE[i] = cosf(a); ROPE[SEQ * 32 + i] = sinf(a); }
        for (int i = bx * 512 + tid; i < 2 * 64 * 128; i += G * 512) { const int j = i / (64 * 128), r = (i / 128) % 64, c = i % 128; *(u32x4*)((bf16*)(ws + OFF_WA + j * SZ_WA) + (size_t)(448 + r) * 1024 + c * 8) = (u32x4){0u, 0u, 0u, 0u}; }
        for (int i = bx * 512 + tid; i < 2 * 1024 * 64; i += G * 512) { const int j = i >> 16, r = (i >> 6) & 1023, h = (i >> 3) & 7, c = i & 7; *(u32x4*)((bf16*)(ws + OFF_WO + j * SZ_WO) + (size_t)r * 1536 + h * 192 + 128 + c * 8) = (u32x4){0u, 0u, 0u, 0u}; }
        LAS float* scr = (LAS float*)(lds + wave * 16384);
        for (int it = GW; it < IT_END; it += NGW_) convert_item(it, scr, lane);
    }
    GSYNC();
    {
        int tidv = threadIdx.x; asm volatile("" : "+v"(tidv));
        const int tid2 = tidv, lane2 = tid2 & 63, wave2 = __builtin_amdgcn_readfirstlane(tid2 >> 6);
        for (int u = BX(); u < 408; u += GD()) bias_unit(u, lds, tid2, wave2, lane2);
        unsigned char* ws = ldws();
        first_aprime(ldp(I_X), ldp(I_CTX), ldp(I_GNORM), (const float*)(ws + OFF_MOD) + D, (bf16*)(ws + OFF_NH), (float*)(ws + OFF_SS), BX() * NWAVES + wave2, NGW_, lane2);
    }
    GSYNC();

#pragma unroll 1
    for (int it = 0; it < 3 * DEPTH; ++it) {
        {
            int itv = it; asm volatile("" : "+s"(itv));
            int tidv = threadIdx.x; asm volatile("" : "+v"(tidv));
            const int tid = tidv, lane = tid & 63, wave = __builtin_amdgcn_readfirstlane(tid >> 6);
            const int l = itv / 3, s = itv - 3 * l;
            const int kind = l & 1, j = l >> 1; const bool last = (l == DEPTH - 1);
            unsigned char* const ws = ldws();
            const int rows_out = (last && s >= 1) ? RL : RT;
            const float* SSc = (const float*)(ws + OFF_SS);
            if (s != 1) {
                const int m = l * 2 + (s >> 1);
                pg8::GemmT<2 * DFF, D, D> g{(const bf16*)(ws + OFF_NH), (const bf16*)(ws + OFF_WUP + m * SZ_WUP), rows_out}; pg8::StaticOrder S; S.init(rows_out, 2 * DFF, GD(), BX());
                pg8::EpiSwiGLU E{(bf16*)(ws + OFF_ACT), DFF, SSc, (const float*)(ws + OFF_BIAS) + BIAS_UP + (size_t)m * 17 * 5632};
                pg8::gemm_phase<pg8::EpiSwiGLU, pg8::StaticOrder, true, true>(lds, g, S, E);
                GSYNC();
            } else if (kind == 0) {
                { pg8::GemmT<3072, D, D> g{(const bf16*)(ws + OFF_NH), (const bf16*)(ws + OFF_WIN + j * SZ_WIN), rows_out}; pg8::StaticOrder S; S.init(rows_out, 3072, GD(), BX());
                  pg8::EpiWin E{(bf16*)(ws + OFF_BB), (bf16*)(ws + OFF_VV), SSc, (const float*)(ws + OFF_BIAS) + BIAS_WIN + (size_t)j * 17 * 3072};
                  pg8::gemm_phase<pg8::EpiWin, pg8::StaticOrder, true, true>(lds, g, S, E); }
                GSYNC();
                { conv_phase((const bf16*)(ws + OFF_BB), (const bf16*)(ws + OFF_VV), ldp(I_SCCONV) + (size_t)j * 3 * D, (bf16*)(ws + OFF_YY), BX() * 512 + tid, GD() * 512); }
                GSYNC();
            } else {
                { pg8::GemmT<512, D, D> g{(const bf16*)(ws + OFF_NH), (const bf16*)(ws + OFF_WA + j * SZ_WA), RT}; pg8::StaticOrder S; S.init(RT, 512, GD(), BX());
                  pg8::EpiBf16 E{(bf16*)(ws + OFF_CQKV), 512, nullptr, SSc, (const float*)(ws + OFF_BIAS) + BIAS_WA + (size_t)j * 17 * 512, (float*)(ws + OFF_STAT)};
                  pg8::gemm_phase<pg8::EpiBf16, pg8::StaticOrder, true, true>(lds, g, S, E); }
                GSYNC();
                { const float* RS4 = (const float*)(ws + OFF_STAT);
                  pg8::GemmT<1536, 256, 512> g{(const bf16*)(ws + OFF_CQKV), (const bf16*)(ws + OFF_WUQ + j * SZ_WUQ), rows_out}; pg8::StaticOrder S; S.init(rows_out, 1536, GD(), BX());
                  pg8::EpiBf16 E{(bf16*)(ws + OFF_Q), 1536, RS4, nullptr, nullptr, nullptr};
                  pg8::gemm_phase<pg8::EpiBf16, pg8::StaticOrder, true, true>(lds, g, S, E); }
                { const float* RS4 = (const float*)(ws + OFF_STAT);
                  pg8::GemmT<2048, 128, 512> g{(const bf16*)(ws + OFF_CQKV) + 256, (const bf16*)(ws + OFF_WUKV + j * SZ_WUKV), RT}; pg8::StaticOrder S; S.init(RT, 2048, GD(), BX());
                  pg8::EpiKV E{(bf16*)(ws + OFF_K), (bf16*)(ws + OFF_V), RS4};
                  pg8::gemm_phase<pg8::EpiKV, pg8::StaticOrder, true, true>(lds, g, S, E); }
                GSYNC();
#ifndef NO_FIN
                { finalize_phase((bf16*)(ws + OFF_Q), (bf16*)(ws + OFF_K), (const bf16*)(ws + OFF_CQKV), ldp(I_GQ) + j * 192, ldp(I_GK) + j * 192, (const float*)(ws + OFF_ROPE), false, GW, NGW_, lane); }
#endif
                GSYNC();
#ifndef NO_ATTN
                { const int G = GD(), bx = BX();
                  bf16* Qb = (bf16*)(ws + OFF_Q); const bf16* Kb = (const bf16*)(ws + OFF_K); const bf16* Vb = (const bf16*)(ws + OFF_V);
                  const int vcu = (G % 8 == 0) ? (bx % 8) * (G / 8) + bx / 8 : bx;
                  const int nunits = 1024 + (last ? 0 : 128); const float* gqp = ldp(I_GQ) + j * 192; const float* ropep = (const float*)(ws + OFF_ROPE);
                  for (int u = vcu; u < nunits; u += G) {
                      int b, h, q0, nt;
                      if (u < 1024) { b = u >> 6; h = (u >> 3) & 7; q0 = b * SEQ + (u & 7) * 256; nt = 36; }
                      else { b = (u - 1024) >> 3; h = (u - 1024) & 7; q0 = RL + b * CTXL; nt = 4; }
                      att::attn_unit(Qb, Kb, Vb, Qb, q0, h, nt, 4, RL + b * CTXL, b * SEQ, (char*)lds_raw, gqp, ropep, u < 1024);
                  } }
#endif
                GSYNC();
            }
            {
                const bool first = (itv == 0); const int m = l * 2 + (s >> 1);
                float* out = (float*)ldp_raw(I_OUT); float* hctx = (float*)(ws + OFF_HCTX);
                const int nx = itv + 1, ln = nx / 3, sn = nx - 3 * ln; const bool has_next = nx < 3 * DEPTH;
                const int half = (s != 1) ? 1 : 0;
                const bool split = (rows_out == RT) && (GD() == 256);
                float* part = (float*)(ws + OFF_BIG + ((s == 1 && kind == 0) ? 216 : 200) * MiB);
                const float* hin_c = first ? ldp(I_CTX) : hctx;
                const float* gatep = (const float*)(ws + OFF_MOD) + (size_t)l * NCOND * MODW + (3 * s + 2) * D;
                const float* scnp = (const float*)(ws + OFF_MOD) + (size_t)ln * NCOND * MODW + (3 * sn + 1) * D;
                const float* gnp = has_next ? ldp(I_GNORM) + (size_t)nx * D : nullptr;
#define MAKE_RES(NTF_) pg8::EpiRes E{first ? ldp(I_X) : out, hin_c, out, hctx, gatep, half, (bf16*)(ws + OFF_NH), (float*)(ws + OFF_SS), gnp, scnp, part, (NTF_) / 4}
#define RUN_RES(GT, AP, BP) do { GT g{AP, BP, rows_out}; MAKE_RES(GT::K / 64); \
                    if (split) { pg8::SplitCtxOrder S; S.init(RL, D, GD(), BX(), GT::K / 64); pg8::gemm_phase<pg8::EpiRes, pg8::SplitCtxOrder, true, true>(lds, g, S, E); } \
                    else { pg8::StaticOrder S; S.init(rows_out, D, GD(), BX()); pg8::gemm_phase<pg8::EpiRes, pg8::StaticOrder, true, true>(lds, g, S, E); } } while (0)
                if (s != 1) RUN_RES(GemmDn, (const bf16*)(ws + OFF_ACT), (const bf16*)(ws + OFF_WDN + m * SZ_WDN));
                else if (kind == 0) RUN_RES(GemmSq, (const bf16*)(ws + OFF_YY), (const bf16*)(ws + OFF_WOUT + j * SZ_SQ));
                else RUN_RES(GemmWo, (const bf16*)(ws + OFF_Q), (const bf16*)(ws + OFF_WO + j * SZ_WO));
#undef RUN_RES
#undef MAKE_RES
                if (split) {
                    GSYNC();
                    ctx_fix(hin_c, hctx, part, gatep + (size_t)16 * MODW, half ? 0.5f : 1.0f, (bf16*)(ws + OFF_NH), (float*)(ws + OFF_SS), gnp, scnp + (size_t)16 * MODW, GW, NGW_, lane);
                }
            }
            GSYNC();
        }
    }
}

extern "C" void kernel_launch(void* const* d_in, const int* in_sizes, int n_in, void* d_out, int out_size, void* d_ws, size_t ws_size, hipStream_t stream) {
    static int grid = 0;
    if (grid == 0) {
        if (n_in != N_IN || out_size != RL * D || ws_size < WS_END) { fprintf(stderr, "kernel_launch: unexpected shapes: n_in %d out %d ws %zu (need %zu)\n", n_in, out_size, ws_size, (size_t)WS_END); grid = -1; return; }
        int dev = 0, cus = 0, per_cu = 0;
        hipGetDevice(&dev); hipDeviceGetAttribute(&cus, hipDeviceAttributeMultiprocessorCount, dev);
        if (hipFuncSetAttribute((const void*)fwd_megakernel, hipFuncAttributeMaxDynamicSharedMemorySize, LDS_BYTES) != hipSuccess) { fprintf(stderr, "kernel_launch: hipFuncSetAttribute failed\n"); grid = -1; return; }
        if (hipOccupancyMaxActiveBlocksPerMultiprocessor(&per_cu, (const void*)fwd_megakernel, NWAVES * 64, LDS_BYTES) != hipSuccess || per_cu < 1) { fprintf(stderr, "kernel_launch: occupancy query says %d\n", per_cu); per_cu = 1; }
        (void)hipGetLastError();
        grid = cus * (per_cu > 1 ? 1 : per_cu);
        fprintf(stderr, "kernel_launch: grid %d (cus %d per_cu %d) ws %zu\n", grid, cus, per_cu, ws_size);
    }
    if (grid < 0) return;
    if (hipMemsetAsync((char*)d_ws + OFF_CTL, 0, CTL_BYTES, stream) != hipSuccess) { fprintf(stderr, "kernel_launch: memset failed\n"); return; }
    Params p{};
    for (int i = 0; i < N_IN; ++i) p.in[i] = (const float*)d_in[i];
    p.out = (float*)d_out; p.ws = (unsigned char*)d_ws; p.pad0 = 0; p.pad1 = 0;
    void* args[] = {&p};
    hipError_t e = hipLaunchCooperativeKernel((const void*)fwd_megakernel, dim3(grid), dim3(NWAVES * 64), args, LDS_BYTES, stream);
    if (e != hipSuccess) fprintf(stderr, "cooperative launch failed: %s (grid %d)\n", hipGetErrorString(e), grid);
}
```

```cpp
#include <hip/hip_runtime.h>
#include <hip/hip_cooperative_groups.h>
#include <cstdio>
#include <cstdint>
namespace cg = cooperative_groups;
namespace pg8 {
#define PG8_LAS __attribute__((address_space(3)))
typedef unsigned short bf16_t;
typedef short bf16x8 __attribute__((ext_vector_type(8)));
typedef float f32x4 __attribute__((ext_vector_type(4)));
typedef unsigned u32x4 __attribute__((ext_vector_type(4)));
typedef unsigned u32x2 __attribute__((ext_vector_type(2)));
constexpr int BM = 256, BK = 64, HALF = 128, HTB = HALF * BK * 2  , STAGE_BYTES = 8 * HTB, NXCD = 8, WGM = 8;

__device__ __forceinline__ float xrow_sum(float v) {
    { auto r_ = __builtin_amdgcn_permlane16_swap(__float_as_uint(v), __float_as_uint(v), false, false); v = __uint_as_float(r_[0]) + __uint_as_float(r_[1]); }
    { auto r_ = __builtin_amdgcn_permlane32_swap(__float_as_uint(v), __float_as_uint(v), false, false); v = __uint_as_float(r_[0]) + __uint_as_float(r_[1]); }
    return v;
}
__host__ __device__ __forceinline__ int lds_byte(int r, int c) { const int st = (r >> 4) * 2 + (c >> 5), rr = r & 15, cc = c & 31, ob = rr * 64 + cc * 2; return st * 1024 + (ob ^ (((ob >> 9) & 1) << 5)); }
__host__ __device__ __forceinline__ void stage_rc(int b, int& R, int& C) { const int st = b / 1024, sb = b % 1024, swz = sb ^ (((sb >> 9) & 1) << 5); R = (st >> 1) * 16 + swz / 64; C = (st & 1) * 32 + (swz % 64) / 2; }
__host__ __device__ __forceinline__ int perm32(int rho) { const int n = rho >> 4, i = rho & 15; return 8 * (i >> 2) + 4 * n + (i & 3); }

struct Unit { int pm, pn, k0, nt; };
template <int N_, int K_, int LDA_> struct GemmT { const bf16_t* A; const bf16_t* Bt; int M; static constexpr int N = N_, K = K_, lda = LDA_; };

struct StaticOrder {
    int nM, nN, nwg, G, c;
    __host__ __device__ void init(int M, int N, int G_, int c_) { nM = M / BM; nN = N / BM; nwg = nM * nN; G = G_; c = c_; }
    __host__ __device__ bool next(int i, Unit& u) const {
        const long L = (long)i * G + c; if (L >= nwg) return false;
        int wgid = (int)L; { const int q = nwg / NXCD, r = nwg % NXCD, xcd = wgid % NXCD, off = wgid / NXCD; wgid = (xcd < r ? xcd * (q + 1) : r * (q + 1) + (xcd - r) * q) + off; }
        const int nig = WGM * nN, gid = wgid / nig, fm = gid * WGM, gsz = (nM - fm) < WGM ? (nM - fm) : WGM;
        u.pm = fm + ((wgid % nig) % gsz); u.pn = (wgid % nig) / gsz; u.k0 = 0; u.nt = 0; return true;
    }
    __device__ __forceinline__ void a_ready(const Unit&) const {}
    __device__ __forceinline__ void done(const Unit&) const {}
};


struct SplitCtxOrder {
    StaticOrder lat; int c, ntf;
    __host__ __device__ void init(int Mlat, int N, int G_, int c_, int ntf_) { lat.init(Mlat, N, G_, c_); c = c_; ntf = ntf_; }
    __host__ __device__ bool next(int i, Unit& u) const {
        if (i < 2) return lat.next(i, u);
        if (i > 2) return false;
        const int cu = c >> 2, kq = c & 3, base = ntf >> 2, odd = base & 1;
        u.pm = 128 + (cu >> 2); u.pn = cu & 3;
        u.k0 = kq * base + (odd ? (kq & 1) : 0); u.nt = base + (odd ? ((kq & 1) ? -1 : 1) : 0);
        return true;
    }
    __device__ __forceinline__ void a_ready(const Unit&) const {}
    __device__ __forceinline__ void done(const Unit&) const {}
};
__device__ __forceinline__ unsigned cvt_pk_bf16(float lo, float hi) { unsigned r; asm volatile("v_cvt_pk_bf16_f32 %0, %1, %2" : "=v"(r) : "v"(lo), "v"(hi)); return r; }
__device__ __forceinline__ u32x4 pack8(const f32x4 v0, const f32x4 v1) { u32x4 w; w.x = cvt_pk_bf16(v0[0], v0[1]); w.y = cvt_pk_bf16(v0[2], v0[3]); w.z = cvt_pk_bf16(v1[0], v1[1]); w.w = cvt_pk_bf16(v1[2], v1[3]); return w; }
__device__ __forceinline__ float silu_f(float a) { return a * __builtin_amdgcn_rcpf(1.0f + __builtin_amdgcn_exp2f(-1.4426950408889634f * a)); }

#define PG8_GAS __attribute__((address_space(1)))
constexpr int RL_ROWS = 32768;
__device__ __forceinline__ float row_rs(const float* ssp, int row) { const PG8_GAS f32x4* p = (const PG8_GAS f32x4*)(ssp + (size_t)row * 16); const f32x4 a = p[0], b = p[1], c = p[2], d = p[3];
    const float s = ((a[0] + a[1]) + (a[2] + a[3])) + ((b[0] + b[1]) + (b[2] + b[3])) + (((c[0] + c[1]) + (c[2] + c[3])) + ((d[0] + d[1]) + (d[2] + d[3]))); return rsqrtf(s * (1.0f / 1024.0f) + 1e-6f); }

constexpr int RS_LDS_OFF = 131072;
__device__ __forceinline__ void tile_rs_build(const float* ss, int rowt, int wr, int wc, int fr, int fq) {
    const int t = (wr * 4 + wc) * 64 + fq * 16 + fr;
    if (t < 256) ((PG8_LAS float*)(uintptr_t)RS_LDS_OFF)[t] = row_rs(ss, rowt + t);
    asm volatile("s_waitcnt lgkmcnt(0)" ::: "memory"); __builtin_amdgcn_s_barrier(); asm volatile("" ::: "memory");
}
__device__ __forceinline__ float tile_rs(int rloc) { return ((const PG8_LAS float*)(uintptr_t)RS_LDS_OFF)[rloc]; }
struct EpiSwiGLU {
    static constexpr bool PERM = true, AFTER_DRAIN = false;
    bf16_t* O; int ldc; const float* ss; const float* bias;
    __device__ __forceinline__ void operator()(const f32x4 (&acc)[2][2][4][2], const Unit& u, int wr, int wc, int fr, int fq) const {
        const int rowt = u.pm * BM, cond = rowt < RL_ROWS ? (rowt >> 11) : 16;
        const int row0 = rowt + wr * 64 + fr, col0 = u.pn * HALF + wc * 32 + 8 * fq;
        const float* bp = bias + (size_t)cond * (2 * ldc) + u.pn * BM + wc * 32 + 8 * fq;
        f32x4 bv[2][2];
#pragma unroll
        for (int bj = 0; bj < 2; ++bj)
#pragma unroll
            for (int n = 0; n < 2; ++n) bv[bj][n] = *(const f32x4*)(bp + bj * HALF + 4 * n);
        tile_rs_build(ss, rowt, wr, wc, fr, fq);
#pragma unroll
        for (int ai = 0; ai < 2; ++ai)
#pragma unroll
            for (int m = 0; m < 4; ++m) { const int row = row0 + ai * HALF + m * 16; const float rs = tile_rs(row - rowt); bf16_t* rowp = O + (size_t)row * ldc + col0;
                f32x4 v0, v1;
#pragma unroll
                for (int j = 0; j < 4; ++j) { v0[j] = silu_f(acc[ai][0][m][0][j] * rs + bv[0][0][j]) * (acc[ai][1][m][0][j] * rs + bv[1][0][j]); v1[j] = silu_f(acc[ai][0][m][1][j] * rs + bv[0][1][j]) * (acc[ai][1][m][1][j] * rs + bv[1][1][j]); }
                *(PG8_GAS u32x4*)rowp = pack8(v0, v1); }
    }
};
struct EpiBf16 {
    static constexpr bool PERM = true, AFTER_DRAIN = false;
    bf16_t* O; int ldc; const float* rs4; const float* ss; const float* bias; float* sqout;
    __device__ __forceinline__ void operator()(const f32x4 (&acc)[2][2][4][2], const Unit& u, int wr, int wc, int fr, int fq) const {
        const int rowt = u.pm * BM, cond = rowt < RL_ROWS ? (rowt >> 11) : 16;
        const int row0 = rowt + wr * 64 + fr, col0 = u.pn * BM + wc * 32 + 8 * fq;
        f32x4 bv[2][2];
#pragma unroll
        for (int bj = 0; bj < 2; ++bj)
#pragma unroll
            for (int n = 0; n < 2; ++n) bv[bj][n] = bias ? *(const f32x4*)(bias + (size_t)cond * ldc + col0 + bj * HALF + 4 * n) : (f32x4){0.f, 0.f, 0.f, 0.f};
        if (!rs4) tile_rs_build(ss, rowt, wr, wc, fr, fq);
#pragma unroll
        for (int ai = 0; ai < 2; ++ai)
#pragma unroll
            for (int m = 0; m < 4; ++m) { const int row = row0 + ai * HALF + m * 16; float s;
                if (rs4) { const f32x4 p = *(const PG8_GAS f32x4*)(rs4 + (size_t)row * 8); s = rsqrtf(((p[0] + p[1]) + (p[2] + p[3])) * (1.0f / 256.0f) + 1e-6f); } else s = tile_rs(row - rowt);
                bf16_t* rowp = O + (size_t)row * ldc + col0; float sq = 0.f;
#pragma unroll
                for (int bj = 0; bj < 2; ++bj) { const f32x4 v0 = acc[ai][bj][m][0] * s + bv[bj][0], v1 = acc[ai][bj][m][1] * s + bv[bj][1]; *(PG8_GAS u32x4*)(rowp + bj * HALF) = pack8(v0, v1);
                    if (bj == 0 || u.pn == 0) sq += ((v0[0] * v0[0] + v0[1] * v0[1]) + (v0[2] * v0[2] + v0[3] * v0[3])) + ((v1[0] * v1[0] + v1[1] * v1[1]) + (v1[2] * v1[2] + v1[3] * v1[3])); }
                if (sqout) { sq = xrow_sum(sq); if (fq == 0 && u.pn < 2) sqout[(size_t)row * 8 + u.pn * 4 + wc] = sq; } }
    }
};
struct EpiKV {
    static constexpr bool PERM = true, AFTER_DRAIN = false;
    bf16_t* Kb; bf16_t* Vb; const float* rs4;
    __device__ __forceinline__ void operator()(const f32x4 (&acc)[2][2][4][2], const Unit& u, int wr, int wc, int fr, int fq) const {
        const int row0 = u.pm * BM + wr * 64 + fr, c0 = wc * 32 + 8 * fq;
#pragma unroll
        for (int ai = 0; ai < 2; ++ai)
#pragma unroll
            for (int m = 0; m < 4; ++m) { const int row = row0 + ai * HALF + m * 16; const f32x4 p = *(const PG8_GAS f32x4*)(rs4 + (size_t)row * 8 + 4); const float s = rsqrtf(((p[0] + p[1]) + (p[2] + p[3])) * (1.0f / 128.0f) + 1e-6f);
                *(PG8_GAS u32x4*)(Kb + (size_t)row * 1536 + u.pn * 192 + c0) = pack8(acc[ai][0][m][0] * s, acc[ai][0][m][1] * s);
                *(PG8_GAS u32x4*)(Vb + (size_t)row * 1024 + u.pn * 128 + c0) = pack8(acc[ai][1][m][0] * s, acc[ai][1][m][1] * s); }
    }
};
struct EpiWin {
    static constexpr bool PERM = true, AFTER_DRAIN = false;
    bf16_t* Bb; bf16_t* Vb; const float* ss; const float* bias;
    __device__ __forceinline__ void operator()(const f32x4 (&acc)[2][2][4][2], const Unit& u, int wr, int wc, int fr, int fq) const {
        const int rowt = u.pm * BM, cond = rowt < RL_ROWS ? (rowt >> 11) : 16;
        const int row0 = rowt + wr * 64 + fr, c0 = wc * 32 + 8 * fq;
        const float* bp = bias + (size_t)cond * 3072 + u.pn * BM + c0;
        f32x4 bv[2][2];
#pragma unroll
        for (int bj = 0; bj < 2; ++bj)
#pragma unroll
            for (int n = 0; n < 2; ++n) bv[bj][n] = *(const f32x4*)(bp + bj * HALF + 4 * n);
        tile_rs_build(ss, rowt, wr, wc, fr, fq);
        if (u.pn < 4) {
#pragma unroll
            for (int ai = 0; ai < 2; ++ai)
#pragma unroll
                for (int m = 0; m < 4; ++m) { const int row = row0 + ai * HALF + m * 16; const float rs = tile_rs(row - rowt); bf16_t* rowp = Bb + (size_t)row * 1024 + u.pn * BM + c0;
#pragma unroll
                    for (int bj = 0; bj < 2; ++bj) *(PG8_GAS u32x4*)(rowp + bj * HALF) = pack8(acc[ai][bj][m][0] * rs + bv[bj][0], acc[ai][bj][m][1] * rs + bv[bj][1]); }
        } else {
#pragma unroll
            for (int ai = 0; ai < 2; ++ai)
#pragma unroll
                for (int m = 0; m < 4; ++m) { const int row = row0 + ai * HALF + m * 16; const float rs = tile_rs(row - rowt); bf16_t* rowp = Vb + (size_t)row * 1024 + (u.pn - 4) * HALF + c0;
                    *(PG8_GAS u32x4*)rowp = pack8((acc[ai][0][m][0] * rs + bv[0][0]) * (acc[ai][1][m][0] * rs + bv[1][0]), (acc[ai][0][m][1] * rs + bv[0][1]) * (acc[ai][1][m][1] * rs + bv[1][1])); }
        }
    }
};
struct EpiRes {
    static constexpr bool PERM = true, AFTER_DRAIN = false;
    const float* hin_l; const float* hin_c; float* hout_l; float* hout_c; const float* gate;   int half;
    bf16_t* NHn; float* SSn; const float* gn; const float* scn;
    float* part; int kbase;
    __device__ __forceinline__ void operator()(const f32x4 (&acc)[2][2][4][2], const Unit& u, int wr, int wc, int fr, int fq) const {
        if (u.nt != 0) {
            PG8_GAS bf16_t* pp = (PG8_GAS bf16_t*)((bf16_t*)part + ((size_t)(u.k0 / kbase) * 4096 + (size_t)(u.pm * BM - RL_ROWS)) * 1024); const unsigned o0 = (unsigned)((wr * 64 + fr) * 1024 + u.pn * BM + wc * 32 + 8 * fq);
#pragma unroll
            for (int ai = 0; ai < 2; ++ai)
#pragma unroll
                for (int m = 0; m < 4; ++m)
#pragma unroll
                    for (int bj = 0; bj < 2; ++bj) *(PG8_GAS u32x4*)(pp + o0 + (unsigned)((ai * HALF + m * 16) * 1024 + bj * HALF)) = pack8(acc[ai][bj][m][0], acc[ai][bj][m][1]);
            return;
        }
        const int rowt = u.pm * BM; const bool lat = rowt < RL_ROWS; const int cond = lat ? (rowt >> 11) : 16;
        const PG8_GAS float* hi = (const PG8_GAS float*)(lat ? hin_l + (size_t)rowt * 1024 : hin_c + (size_t)(rowt - RL_ROWS) * 1024);
        PG8_GAS float* ho = (PG8_GAS float*)(lat ? hout_l + (size_t)rowt * 1024 : hout_c + (size_t)(rowt - RL_ROWS) * 1024);
        PG8_GAS bf16_t* nht = (PG8_GAS bf16_t*)(NHn + (size_t)rowt * 1024); PG8_GAS float* sst = (PG8_GAS float*)(SSn + (size_t)rowt * 16);
        const int col0 = u.pn * BM + wc * 32 + 8 * fq; const float* gp = gate + (size_t)cond * 9216 + col0;
        f32x4 gv[2][2], gsv[2][2]; const float gs = half ? 0.5f : 1.0f; const bool nxt = gn != nullptr;
#pragma unroll
        for (int bj = 0; bj < 2; ++bj)
#pragma unroll
            for (int n = 0; n < 2; ++n) { gv[bj][n] = *(const f32x4*)(gp + bj * HALF + n * 4) * gs;
                gsv[bj][n] = nxt ? *(const f32x4*)(gn + col0 + bj * HALF + n * 4) * (*(const f32x4*)(scn + (size_t)cond * 9216 + col0 + bj * HALF + n * 4) + 1.0f) : (f32x4){0.f, 0.f, 0.f, 0.f}; }
        const unsigned off0 = (unsigned)((wr * 64 + fr) * 1024 + col0);
#pragma unroll
        for (int g2 = 0; g2 < 4; ++g2) {
            const int ai = g2 >> 1, mb = (g2 & 1) * 2;
            f32x4 pre[2][2][2];
#pragma unroll
            for (int mm = 0; mm < 2; ++mm)
#pragma unroll
                for (int bj = 0; bj < 2; ++bj)
#pragma unroll
                    for (int n = 0; n < 2; ++n) pre[mm][bj][n] = *(const PG8_GAS f32x4*)(hi + off0 + (unsigned)((ai * HALF + (mb + mm) * 16) * 1024 + bj * HALF + n * 4));
#pragma unroll
            for (int mm = 0; mm < 2; ++mm) { const int m = mb + mm; const unsigned off = off0 + (unsigned)((ai * HALF + m * 16) * 1024); float sq = 0.f;
#pragma unroll
                for (int bj = 0; bj < 2; ++bj) { const unsigned o_ = off + (unsigned)(bj * HALF);
                    const f32x4 o0v = pre[mm][bj][0] + gv[bj][0] * acc[ai][bj][m][0], o1v = pre[mm][bj][1] + gv[bj][1] * acc[ai][bj][m][1];
                    *(PG8_GAS f32x4*)(ho + o_) = o0v; *(PG8_GAS f32x4*)(ho + o_ + 4) = o1v;
                    if (nxt) { *(PG8_GAS u32x4*)(nht + o_) = pack8(o0v * gsv[bj][0], o1v * gsv[bj][1]);
                        sq += ((o0v[0] * o0v[0] + o0v[1] * o0v[1]) + (o0v[2] * o0v[2] + o0v[3] * o0v[3])) + ((o1v[0] * o1v[0] + o1v[1] * o1v[1]) + (o1v[2] * o1v[2] + o1v[3] * o1v[3])); } }
                if (nxt) { sq = xrow_sum(sq); if (fq == 0) sst[(size_t)(off >> 10) * 16 + u.pn * 4 + wc] = sq; } }
        }
    }
};

template <class Epi, class Sched, bool ALIGN_EPI, bool SP2, class Gm>
__device__ __forceinline__ void gemm_phase(PG8_LAS unsigned char* lds, const Gm g, const Sched& S, const Epi& E) {
    int tid = threadIdx.x; asm volatile("" : "+v"(tid));
    const int wid = __builtin_amdgcn_readfirstlane(tid >> 6), lane = tid & 63, wr = wid >> 2, wc = wid & 3, fr = lane & 15, fq = lane >> 4;
    constexpr int K = Gm::K, NTF = K / BK;
    unsigned voffA[2], voffB[2];
#pragma unroll
    for (int i = 0; i < 2; ++i) { int R, C; stage_rc(tid * 16 + i * 8192, R, C); const int Rb = Epi::PERM ? ((R & ~31) + perm32(R & 31)) : R;
        voffA[i] = (unsigned)(R * Gm::lda + C) * 2u; voffB[i] = (unsigned)(Rb * K + C) * 2u; }
    constexpr size_t kstep = (size_t)(BK * 2);
    constexpr size_t hstepA = (size_t)HALF * Gm::lda * 2, hstepB = (size_t)HALF * K * 2;
    constexpr size_t tstepA = 2 * hstepA, tstepB = 2 * hstepB;
    const unsigned ldsw = (unsigned)wid * 1024u;
    const int aoff = lds_byte(wr * 64 + fr, fq * 8), boff = lds_byte(wc * 32 + fr, fq * 8);
#define PG8_SA(b, h) (((b) * 2 + (h)) * HTB)
#define PG8_SB(b, h) ((4 + (b) * 2 + (h)) * HTB)
#define PG8_STAGE(bufoff, gbase, voff) do { _Pragma("unroll") for (int _i = 0; _i < 2; ++_i) \
        __builtin_amdgcn_global_load_lds((const unsigned*)((const char*)(gbase) + (voff)[_i]), (PG8_LAS unsigned*)(lds + (bufoff) + ldsw + _i * 8192), 16, 0, 0); } while (0)
#define PG8_LDA(dst, b, h) do { _Pragma("unroll") for (int m = 0; m < 4; ++m) _Pragma("unroll") for (int k = 0; k < 2; ++k) dst[m][k] = *(const PG8_LAS bf16x8*)(lds + PG8_SA(b, h) + aoff + m * 2048 + k * 1024); } while (0)
#define PG8_LDB(dst, b, h) do { _Pragma("unroll") for (int n = 0; n < 2; ++n) _Pragma("unroll") for (int k = 0; k < 2; ++k) dst[n][k] = *(const PG8_LAS bf16x8*)(lds + PG8_SB(b, h) + boff + n * 2048 + k * 1024); } while (0)
#define PG8_MMA(ai, bj, At, Bt) do { __builtin_amdgcn_s_setprio(1); _Pragma("unroll") for (int m = 0; m < 4; ++m) _Pragma("unroll") for (int n = 0; n < 2; ++n) _Pragma("unroll") for (int k = 0; k < 2; ++k) \
        acc[ai][bj][m][n] = __builtin_amdgcn_mfma_f32_16x16x32_bf16(Bt[n][k], At[m][k], acc[ai][bj][m][n], 0, 0, 0); __builtin_amdgcn_s_setprio(0); } while (0)
#define PG8_WAIT_V(n) asm volatile("s_waitcnt vmcnt(" #n ")" ::: "memory")
#define PG8_WAIT_L(n) asm volatile("s_waitcnt lgkmcnt(" #n ")" ::: "memory")
#define PG8_BAR __builtin_amdgcn_s_barrier()
#define PG8_SCHED __builtin_amdgcn_sched_barrier(0)
    Unit cur, nxt; int ui = 0;
    if (!S.next(0, cur)) return;
    int nt = cur.nt ? cur.nt : NTF;
    f32x4 acc[2][2][4][2];
#pragma unroll
    for (int a = 0; a < 2; ++a)
#pragma unroll
        for (int b = 0; b < 2; ++b)
#pragma unroll
            for (int m = 0; m < 4; ++m)
#pragma unroll
                for (int n = 0; n < 2; ++n) acc[a][b][m][n] = (f32x4){0.f, 0.f, 0.f, 0.f};
    bf16x8 At[4][2], B0[2][2], B1[2][2];
    const char* cA = (const char*)g.A + (size_t)cur.pm * tstepA + (size_t)cur.k0 * kstep; const char* cB = (const char*)g.Bt + (size_t)cur.pn * tstepB + (size_t)cur.k0 * kstep;
    S.a_ready(cur);
    if constexpr (SP2) {
        PG8_STAGE(PG8_SB(0, 0), cB, voffB); PG8_STAGE(PG8_SB(0, 1), cB + hstepB, voffB); PG8_STAGE(PG8_SA(0, 0), cA, voffA); PG8_STAGE(PG8_SA(0, 1), cA + hstepA, voffA);
        if (wr == 1) PG8_BAR;
        PG8_WAIT_V(2); PG8_BAR;
        PG8_STAGE(PG8_SB(1, 0), cB + kstep, voffB); PG8_STAGE(PG8_SA(1, 0), cA + kstep, voffA); PG8_STAGE(PG8_SB(1, 1), cB + hstepB + kstep, voffB);
        PG8_WAIT_V(6); PG8_BAR;
    } else {
        PG8_STAGE(PG8_SB(0, 0), cB, voffB); PG8_STAGE(PG8_SA(0, 0), cA, voffA); PG8_STAGE(PG8_SB(0, 1), cB + hstepB, voffB); PG8_STAGE(PG8_SA(0, 1), cA + hstepA, voffA);
        if (wr == 1) PG8_BAR;
        PG8_WAIT_V(4); PG8_BAR;
        PG8_STAGE(PG8_SB(1, 0), cB + kstep, voffB); PG8_STAGE(PG8_SA(1, 0), cA + kstep, voffA); PG8_STAGE(PG8_SB(1, 1), cB + hstepB + kstep, voffB);
        PG8_WAIT_V(6); PG8_BAR;
    }
    for (;;) {
        const bool has_next = S.next(ui + 1, nxt);
        const char* nA = has_next ? (const char*)g.A + (size_t)nxt.pm * tstepA + (size_t)nxt.k0 * kstep : cA; const char* nB = has_next ? (const char*)g.Bt + (size_t)nxt.pn * tstepB + (size_t)nxt.k0 * kstep : cB;
        for (int t = 0; t < nt; t += 2) {
            const bool last = (t == nt - 2);
            const char* a1 = cA + (size_t)(t + 1) * kstep;
            const char* a2 = last ? nA : cA + (size_t)(t + 2) * kstep; const char* b2 = last ? nB : cB + (size_t)(t + 2) * kstep;
            const char* a3 = a2 + kstep; const char* b3 = b2 + kstep;
            if (last && has_next) S.a_ready(nxt);
            if constexpr (SP2) {
            PG8_LDB(B0, 0, 0); PG8_LDB(B1, 0, 1); PG8_SCHED; PG8_LDA(At, 0, 0); PG8_STAGE(PG8_SA(1, 1), a1 + hstepA, voffA);
            PG8_WAIT_V(8); PG8_WAIT_L(0); PG8_BAR; PG8_MMA(0, 0, At, B0); PG8_MMA(0, 1, At, B1); PG8_BAR; PG8_SCHED;
            PG8_LDA(At, 0, 1); PG8_STAGE(PG8_SB(0, 0), b2, voffB); PG8_STAGE(PG8_SB(0, 1), b2 + hstepB, voffB); PG8_STAGE(PG8_SA(0, 0), a2, voffA);
            PG8_WAIT_V(8); PG8_WAIT_L(0); PG8_BAR; PG8_MMA(1, 0, At, B0); PG8_MMA(1, 1, At, B1); PG8_BAR; PG8_SCHED;
            PG8_LDB(B0, 1, 0); PG8_LDB(B1, 1, 1); PG8_SCHED; PG8_LDA(At, 1, 0); PG8_STAGE(PG8_SA(0, 1), a2 + hstepA, voffA);
            PG8_WAIT_V(8); PG8_WAIT_L(0); PG8_BAR; PG8_MMA(0, 0, At, B0); PG8_MMA(0, 1, At, B1); PG8_BAR; PG8_SCHED;
            PG8_LDA(At, 1, 1); PG8_STAGE(PG8_SB(1, 0), b3, voffB); PG8_STAGE(PG8_SB(1, 1), b3 + hstepB, voffB); PG8_STAGE(PG8_SA(1, 0), a3, voffA);
            PG8_WAIT_V(8); PG8_WAIT_L(0); PG8_BAR; PG8_MMA(1, 0, At, B0); PG8_MMA(1, 1, At, B1); PG8_BAR; PG8_SCHED;
            } else {
            PG8_LDB(B0, 0, 0); PG8_SCHED; PG8_LDA(At, 0, 0); PG8_STAGE(PG8_SA(1, 1), a1 + hstepA, voffA);
            PG8_WAIT_L(8); PG8_BAR; PG8_WAIT_L(0); PG8_MMA(0, 0, At, B0); PG8_BAR; PG8_SCHED;
            PG8_LDB(B1, 0, 1); PG8_STAGE(PG8_SB(0, 0), b2, voffB);
            PG8_BAR; PG8_WAIT_L(0); PG8_MMA(0, 1, At, B1); PG8_BAR;
            PG8_LDA(At, 0, 1); PG8_STAGE(PG8_SA(0, 0), a2, voffA);
            PG8_BAR; PG8_WAIT_L(0); PG8_MMA(1, 0, At, B0); PG8_BAR; PG8_SCHED;
            PG8_STAGE(PG8_SB(0, 1), b2 + hstepB, voffB);
            PG8_WAIT_V(6); PG8_BAR; PG8_MMA(1, 1, At, B1); PG8_BAR;
            PG8_LDB(B0, 1, 0); PG8_SCHED; PG8_LDA(At, 1, 0); PG8_STAGE(PG8_SA(0, 1), a2 + hstepA, voffA);
            PG8_WAIT_L(8); PG8_BAR; PG8_WAIT_L(0); PG8_MMA(0, 0, At, B0); PG8_BAR; PG8_SCHED;
            PG8_LDB(B1, 1, 1); PG8_STAGE(PG8_SB(1, 0), b3, voffB);
            PG8_BAR; PG8_WAIT_L(0); PG8_MMA(0, 1, At, B1); PG8_BAR;
            PG8_LDA(At, 1, 1); PG8_STAGE(PG8_SA(1, 0), a3, voffA);
            PG8_BAR; PG8_WAIT_L(0); PG8_MMA(1, 0, At, B0); PG8_BAR; PG8_SCHED;
            PG8_STAGE(PG8_SB(1, 1), b3 + hstepB, voffB);
            PG8_WAIT_V(6); PG8_BAR; PG8_MMA(1, 1, At, B1); PG8_BAR;
            }
        }
        if constexpr (ALIGN_EPI) { if (wr == 0) PG8_BAR; }
        if constexpr (!Epi::AFTER_DRAIN) { E(acc, cur, wr, wc, fr, fq); S.done(cur); }
        if (!has_next) break;
#pragma unroll
        for (int a = 0; a < 2; ++a)
#pragma unroll
            for (int b = 0; b < 2; ++b)
#pragma unroll
                for (int m = 0; m < 4; ++m)
#pragma unroll
                    for (int n = 0; n < 2; ++n) acc[a][b][m][n] = (f32x4){0.f, 0.f, 0.f, 0.f};
        cur = nxt; cA = nA; cB = nB; ++ui; nt = cur.nt ? cur.nt : NTF;
        if constexpr (ALIGN_EPI) { if (wr == 1) PG8_BAR; }
    }
    PG8_WAIT_V(0);
    if constexpr (!ALIGN_EPI) { if (wr == 0) PG8_BAR; }
    PG8_BAR;
    if constexpr (Epi::AFTER_DRAIN) { E.fused(acc, cur, wr, wc, fr, fq, lds, wid, lane); S.done(cur); }
#undef PG8_SA
#undef PG8_SB
#undef PG8_STAGE
#undef PG8_LDA
#undef PG8_LDB
#undef PG8_MMA
#undef PG8_WAIT_V
#undef PG8_WAIT_L
#undef PG8_BAR
#undef PG8_SCHED
}
}
namespace att {
using bf16x8 = __attribute__((ext_vector_type(8))) short;
using s16x4  = __attribute__((ext_vector_type(4))) short;
using f32x16 = __attribute__((ext_vector_type(16))) float;
using u32x4  = __attribute__((ext_vector_type(4))) unsigned;
typedef unsigned short bf16_t;
#define ATT_GAS __attribute__((address_space(1)))
constexpr int DQK = 192, DV = 128, NW = 8, QBLK = 32, KVBLK = 64;
constexpr int LDQ = 1536, LDKK = 1536, LDV = 1024, LDO = 1536;
constexpr int QREG = 6;
constexpr int SHM_V = KVBLK * DV * 2, SHM_K = KVBLK * DQK * 2, SHM_WS = NW * 64 * 4, SHM_QOFF = 2 * SHM_V + 2 * SHM_K + SHM_WS, SHM_ATTN = SHM_QOFF + NW * (12 - QREG) * 1024;
typedef float f32x4_ __attribute__((ext_vector_type(4)));
constexpr float QSCALE = 0.07216878364870322f * 1.4426950408889634f;
constexpr float THR = 8.0f;
#define KSWZ(row, colB) ((row) * 384 + ((colB) ^ (((row) & 7) << 4)))
#define SBAR() __builtin_amdgcn_sched_barrier(0)
__device__ __forceinline__ int crow(int r, int hi) { return (r & 3) + 8 * (r >> 2) + 4 * hi; }
__device__ __forceinline__ unsigned cvtpk(float lo, float hi) { unsigned r; asm volatile("v_cvt_pk_bf16_f32 %0, %1, %2" : "=v"(r) : "v"(lo), "v"(hi)); return r; }

__device__ __forceinline__ void partialSM(f32x16& p0, f32x16& p1, float& m_reg, float& mn, float& alpha) {
  float pmax = p0[0];
#pragma unroll
  for (int r = 1; r < 16; ++r) pmax = fmaxf(pmax, p0[r]);
#pragma unroll
  for (int r = 0; r < 16; ++r) pmax = fmaxf(pmax, p1[r]);
  { auto rr = __builtin_amdgcn_permlane32_swap(__float_as_uint(pmax), __float_as_uint(pmax), false, false);
    pmax = fmaxf(__uint_as_float(rr[0]), __uint_as_float(rr[1])); }
  if (__builtin_expect(__all(pmax - m_reg <= THR), 1)) { mn = m_reg; alpha = 1.f; }
  else { mn = fmaxf(m_reg, pmax); alpha = __builtin_amdgcn_exp2f(m_reg - mn); m_reg = mn; }
#pragma unroll
  for (int r = 0; r < 16; ++r) p0[r] = p0[r] - mn;
#pragma unroll
  for (int r = 0; r < 16; ++r) p1[r] = p1[r] - mn;
#pragma unroll
  for (int r = 0; r < 16; ++r) p0[r] = __builtin_amdgcn_exp2f(p0[r]);
}
__device__ __forceinline__ void finishSM(f32x16& p0, f32x16& p1, float alpha, float& l_reg, bf16x8& pa0, bf16x8& pa1, bf16x8& pa2, bf16x8& pa3) {
#pragma unroll
  for (int r = 0; r < 16; ++r) p1[r] = __builtin_amdgcn_exp2f(p1[r]);
  float ps = 0;
#pragma unroll
  for (int r = 0; r < 16; ++r) ps += p0[r];
#pragma unroll
  for (int r = 0; r < 16; ++r) ps += p1[r];
  { auto rr = __builtin_amdgcn_permlane32_swap(__float_as_uint(ps), __float_as_uint(ps), false, false);
    ps = __uint_as_float(rr[0]) + __uint_as_float(rr[1]); }
  l_reg = l_reg * alpha + ps;
#define PK4(P, BASE, OUT) do { unsigned a0 = cvtpk(P[BASE + 0], P[BASE + 1]), a1 = cvtpk(P[BASE + 2], P[BASE + 3]);   \
    unsigned b0 = cvtpk(P[BASE + 4], P[BASE + 5]), b1 = cvtpk(P[BASE + 6], P[BASE + 7]);                              \
    auto r0 = __builtin_amdgcn_permlane32_swap(a0, b0, false, false); auto r1 = __builtin_amdgcn_permlane32_swap(a1, b1, false, false); \
    u32x4 w = {r0[0], r1[0], r0[1], r1[1]}; OUT = __builtin_bit_cast(bf16x8, w); } while (0)
  PK4(p0, 0, pa0); PK4(p0, 8, pa1); PK4(p1, 0, pa2); PK4(p1, 8, pa3);
#undef PK4
}
__device__ __forceinline__ void qkt(f32x16& p0, f32x16& p1, const char* Ks, const bf16x8* qr, const char* ql, int r32, int hi) {
  p0 = f32x16{}; p1 = f32x16{};
#pragma unroll
  for (int d0 = 0; d0 < 12; ++d0) { const int cb = (d0 * 16 + hi * 8) * 2;
    bf16x8 b0 = *reinterpret_cast<const bf16x8*>(Ks + KSWZ(r32, cb));
    bf16x8 b1 = *reinterpret_cast<const bf16x8*>(Ks + KSWZ(32 + r32, cb));
    bf16x8 q;
    if (d0 < QREG) q = qr[d0]; else q = *reinterpret_cast<const bf16x8*>(ql + (d0 - QREG) * 1024);
    p0 = __builtin_amdgcn_mfma_f32_32x32x16_bf16(b0, q, p0, 0, 0, 0);
    p1 = __builtin_amdgcn_mfma_f32_32x32x16_bf16(b1, q, p1, 0, 0, 0); }
}
__device__ __forceinline__ int v_st(int k, int c) { const int kk = (k & ~0xC) | ((k & 4) << 1) | ((k & 8) >> 1); return ((kk >> 3) * 4 + (c >> 5)) * 512 + ((kk & 7) * 32 + (c & 31)) * 2; }
__device__ __forceinline__ int v_rd_base(int lane) { return ((lane & 3) << 3) | (((lane >> 2) & 3) << 6) | (((lane >> 4) & 1) << 5) | (((lane >> 5) & 1) << 8); }
constexpr int v_rd_off(int d0, int ks, int half) { return d0 * 512 + ks * 4096 + half * 2048; }
template <int OFF> __device__ __forceinline__ s16x4 tr_read(int vb) {
  s16x4 r; asm volatile("ds_read_b64_tr_b16 %0, %1 offset:%2" : "=&v"(r) : "v"(vb), "i"(OFF) : "memory"); return r;
}
template <int D0> __device__ __forceinline__ void pv_one(f32x16& od, int vb, bf16x8 pa0, bf16x8 pa1, bf16x8 pa2, bf16x8 pa3) {
  const s16x4 l0 = tr_read<v_rd_off(D0, 0, 0)>(vb), h0 = tr_read<v_rd_off(D0, 0, 1)>(vb), l1 = tr_read<v_rd_off(D0, 1, 0)>(vb), h1 = tr_read<v_rd_off(D0, 1, 1)>(vb);
  const s16x4 l2 = tr_read<v_rd_off(D0, 2, 0)>(vb), h2 = tr_read<v_rd_off(D0, 2, 1)>(vb), l3 = tr_read<v_rd_off(D0, 3, 0)>(vb), h3 = tr_read<v_rd_off(D0, 3, 1)>(vb);
  asm volatile("s_waitcnt lgkmcnt(0)" ::: "memory"); SBAR();
#define PK(L, H) (bf16x8){L[0], L[1], L[2], L[3], H[0], H[1], H[2], H[3]}
  od = __builtin_amdgcn_mfma_f32_32x32x16_bf16(pa0, PK(l0, h0), od, 0, 0, 0);
  od = __builtin_amdgcn_mfma_f32_32x32x16_bf16(pa1, PK(l1, h1), od, 0, 0, 0);
  od = __builtin_amdgcn_mfma_f32_32x32x16_bf16(pa2, PK(l2, h2), od, 0, 0, 0);
  od = __builtin_amdgcn_mfma_f32_32x32x16_bf16(pa3, PK(l3, h3), od, 0, 0, 0);
#undef PK
}
__device__ __forceinline__ void pv_d0(f32x16* o, int vb, bf16x8 pa0, bf16x8 pa1, bf16x8 pa2, bf16x8 pa3) {
  pv_one<0>(o[0], vb, pa0, pa1, pa2, pa3); pv_one<1>(o[1], vb, pa0, pa1, pa2, pa3); pv_one<2>(o[2], vb, pa0, pa1, pa2, pa3); pv_one<3>(o[3], vb, pa0, pa1, pa2, pa3);
}

__device__ __forceinline__ void attn_unit(const bf16_t* __restrict__ Qg, const bf16_t* __restrict__ Kg, const bf16_t* __restrict__ Vg, bf16_t* __restrict__ Og,
                                          int qrow0, int h, int NT, int nctx_t, int kc0, int kl0, char* lds, const float* gq, const float* ropetab, bool lat) {
  int tid = threadIdx.x; asm volatile("" : "+v"(tid));
  const int wid = tid >> 6, lane = tid & 63, r32 = lane & 31, hi = lane >> 5;
  char* V_lds = lds; char* K_lds = lds + 2 * SHM_V;
  float* ws = (float*)(lds + 2 * SHM_V + 2 * SHM_K) + wid * 64; float* li_l = ws; float* al_l = ws + 32;
  float m_reg = -1e30f, l_reg = 0; f32x16 o[4] = {}; bf16x8 qr[QREG];
  char* ql = lds + SHM_QOFF + wid * ((12 - QREG) * 1024) + lane * 16;
  const ATT_GAS bf16_t* Qw = (const ATT_GAS bf16_t*)(Qg + (size_t)(qrow0 + wid * QBLK + r32) * LDQ + h * DQK + hi * 8);
  { u32x4 qraw[12];
#pragma unroll
    for (int d0 = 0; d0 < 12; ++d0) qraw[d0] = *(const ATT_GAS u32x4*)(Qw + d0 * 16);
    float ss = 0.f;
#pragma unroll
    for (int d0 = 0; d0 < 12; ++d0) { const u32x4 w = qraw[d0];
#pragma unroll
      for (int i = 0; i < 4; ++i) { const float lo = __builtin_bit_cast(float, w[i] << 16), hi_ = __builtin_bit_cast(float, w[i] & 0xffff0000u); ss += lo * lo + hi_ * hi_; } }
    { auto rr = __builtin_amdgcn_permlane32_swap(__float_as_uint(ss), __float_as_uint(ss), false, false); ss = __uint_as_float(rr[0]) + __uint_as_float(rr[1]); }
    const float rq = rsqrtf(ss * (1.0f / 192.0f) + 1e-6f) * QSCALE;
    const ATT_GAS float* gp = (const ATT_GAS float*)gq + hi * 8;
    const int tpos = (qrow0 + wid * QBLK + r32) & 2047;
#define QUNPK(W, X) do { _Pragma("unroll") for (int i_ = 0; i_ < 4; ++i_) { X[2 * i_] = __builtin_bit_cast(float, W[i_] << 16); X[2 * i_ + 1] = __builtin_bit_cast(float, W[i_] & 0xffff0000u); } } while (0)
#define QPUT(D0, Y) do { u32x4 w_ = {cvtpk(Y[0], Y[1]), cvtpk(Y[2], Y[3]), cvtpk(Y[4], Y[5]), cvtpk(Y[6], Y[7])}; const bf16x8 f_ = __builtin_bit_cast(bf16x8, w_); \
      if ((D0) < QREG) qr[(D0) < QREG ? (D0) : 0] = f_; else *reinterpret_cast<bf16x8*>(ql + ((D0) - QREG) * 1024) = f_; } while (0)
#pragma unroll
    for (int d0 = 0; d0 < 8; ++d0) { float x[8]; QUNPK(qraw[d0], x); const f32x4_ g0 = *(const ATT_GAS f32x4_*)(gp + d0 * 16), g1 = *(const ATT_GAS f32x4_*)(gp + d0 * 16 + 4);
#pragma unroll
      for (int i = 0; i < 4; ++i) { x[i] = x[i] * rq * g0[i]; x[4 + i] = x[4 + i] * rq * g1[i]; }
      QPUT(d0, x); }
#pragma unroll
    for (int ax = 0; ax < 2; ++ax) { float x1[8], x2[8]; QUNPK(qraw[8 + 2 * ax], x1); QUNPK(qraw[9 + 2 * ax], x2);
      const f32x4_ ga0 = *(const ATT_GAS f32x4_*)(gp + (8 + 2 * ax) * 16), ga1 = *(const ATT_GAS f32x4_*)(gp + (8 + 2 * ax) * 16 + 4), gb0 = *(const ATT_GAS f32x4_*)(gp + (9 + 2 * ax) * 16), gb1 = *(const ATT_GAS f32x4_*)(gp + (9 + 2 * ax) * 16 + 4);
      const ATT_GAS float* ct = (const ATT_GAS float*)ropetab + ((size_t)tpos * 2 + ax) * 16 + hi * 8;
      const f32x4_ c0 = *(const ATT_GAS f32x4_*)ct, c1 = *(const ATT_GAS f32x4_*)(ct + 4), s0 = *(const ATT_GAS f32x4_*)(ct + 2048 * 32), s1 = *(const ATT_GAS f32x4_*)(ct + 2048 * 32 + 4);
#pragma unroll
      for (int i = 0; i < 8; ++i) { const float g1_ = i < 4 ? ga0[i & 3] : ga1[i & 3], g2_ = i < 4 ? gb0[i & 3] : gb1[i & 3], c = i < 4 ? c0[i & 3] : c1[i & 3], s = i < 4 ? s0[i & 3] : s1[i & 3];
        const float y1 = x1[i] * rq * g1_, y2 = x2[i] * rq * g2_; x1[i] = lat ? (y1 * c - y2 * s) : y1; x2[i] = lat ? (y1 * s + y2 * c) : y2; }
      QPUT(8 + 2 * ax, x1); QPUT(9 + 2 * ax, x2); }
#undef QUNPK
#undef QPUT
  }
  const int sr = tid >> 4, sc = (tid & 15) * 8, vst0 = v_st(sr, sc), vst1 = v_st(32 + sr, sc);
  const int kr0 = tid / 24, kc0_ = (tid % 24) * 8, kr1 = (tid + 512) / 24, kc1_ = ((tid + 512) % 24) * 8, kr2 = (tid + 1024) / 24, kc2_ = ((tid + 1024) % 24) * 8;
  const int kst0 = KSWZ(kr0, kc0_ * 2), kst1 = KSWZ(kr1, kc1_ * 2), kst2 = KSWZ(kr2, kc2_ * 2);
  const int vb0 = (int)(uintptr_t)V_lds + v_rd_base(lane);
  const ATT_GAS bf16_t* Kh = (const ATT_GAS bf16_t*)(Kg + h * DQK); const ATT_GAS bf16_t* Vh = (const ATT_GAS bf16_t*)(Vg + h * DV);
  bf16x8 vs0, vs1, ks0, ks1, ks2;
#define KROW(t) ((t) < nctx_t ? kc0 + 64 * (t) : kl0 + 64 * ((t) - nctx_t))
#define SLOAD(t) do { const size_t k0_ = (size_t)KROW(t); \
    vs0 = *(const ATT_GAS bf16x8*)(&Vh[(k0_ + sr) * LDV + sc]); vs1 = *(const ATT_GAS bf16x8*)(&Vh[(k0_ + 32 + sr) * LDV + sc]); \
    ks0 = *(const ATT_GAS bf16x8*)(&Kh[(k0_ + kr0) * LDKK + kc0_]); ks1 = *(const ATT_GAS bf16x8*)(&Kh[(k0_ + kr1) * LDKK + kc1_]); \
    ks2 = *(const ATT_GAS bf16x8*)(&Kh[(k0_ + kr2) * LDKK + kc2_]); } while (0)
#define SWRITE(b) do { *(bf16x8*)(V_lds + (b) * SHM_V + vst0) = vs0; *(bf16x8*)(V_lds + (b) * SHM_V + vst1) = vs1; \
    *(bf16x8*)(K_lds + (b) * SHM_K + kst0) = ks0; *(bf16x8*)(K_lds + (b) * SHM_K + kst1) = ks1; *(bf16x8*)(K_lds + (b) * SHM_K + kst2) = ks2; } while (0)
#define SWAIT() asm volatile("s_waitcnt vmcnt(0)" ::: "memory")
#define RESC(a) do { if (__any((a) < 1.f)) { if (hi == 0) al_l[r32] = (a); asm volatile("s_waitcnt lgkmcnt(0)" ::: "memory"); \
    _Pragma("unroll") for (int d = 0; d < 4; ++d) _Pragma("unroll") for (int r = 0; r < 16; ++r) o[d][r] *= al_l[crow(r, hi)]; } } while (0)
  f32x16 pA0, pA1, pB0, pB1; float mnA, mnB, alA, alB; bf16x8 pa0, pa1, pa2, pa3;
  SLOAD(0); SWAIT(); SWRITE(0); __syncthreads();
  qkt(pA0, pA1, K_lds, qr, ql, r32, hi); partialSM(pA0, pA1, m_reg, mnA, alA);
  SLOAD(1);
  SWAIT(); SWRITE(1); __syncthreads();
  for (int j = 1; j + 1 < NT; j += 2) {
    SBAR(); qkt(pB0, pB1, K_lds + SHM_K, qr, ql, r32, hi);
    finishSM(pA0, pA1, alA, l_reg, pa0, pa1, pa2, pa3); SBAR();
    SLOAD(j + 1); SBAR();
    pv_d0(o, vb0, pa0, pa1, pa2, pa3); partialSM(pB0, pB1, m_reg, mnB, alB);
    __syncthreads(); SWAIT(); SWRITE(0);
    RESC(alB); __syncthreads();
    SBAR(); qkt(pA0, pA1, K_lds, qr, ql, r32, hi);
    finishSM(pB0, pB1, alB, l_reg, pa0, pa1, pa2, pa3); SBAR();
    SLOAD(j + 2); SBAR();
    pv_d0(o, vb0 + SHM_V, pa0, pa1, pa2, pa3); partialSM(pA0, pA1, m_reg, mnA, alA);
    __syncthreads(); SWAIT(); SWRITE(1);
    RESC(alA); __syncthreads();
  }
  SBAR(); qkt(pB0, pB1, K_lds + SHM_K, qr, ql, r32, hi);
  finishSM(pA0, pA1, alA, l_reg, pa0, pa1, pa2, pa3); SBAR();
  pv_d0(o, vb0, pa0, pa1, pa2, pa3); partialSM(pB0, pB1, m_reg, mnB, alB);
  __syncthreads(); RESC(alB);
  finishSM(pB0, pB1, alB, l_reg, pa0, pa1, pa2, pa3); SBAR();
  pv_d0(o, vb0 + SHM_V, pa0, pa1, pa2, pa3);
  if (hi == 0) li_l[r32] = l_reg; asm volatile("s_waitcnt lgkmcnt(0)" ::: "memory");
  float rli[16];
#pragma unroll
  for (int r = 0; r < 16; ++r) rli[r] = __builtin_amdgcn_rcpf(li_l[crow(r, hi)]);
  ATT_GAS bf16_t* Ow = (ATT_GAS bf16_t*)(Og + (size_t)(qrow0 + wid * QBLK) * LDO + h * DQK);
#pragma unroll
  for (int r = 0; r < 16; ++r) { const int orow = crow(r, hi);
#pragma unroll
    for (int d0 = 0; d0 < 4; ++d0) { const unsigned w = cvtpk(o[d0][r] * rli[r], 0.f); Ow[(size_t)orow * LDO + d0 * 32 + r32] = (bf16_t)(w & 0xffffu); } }
  __syncthreads();
#undef KROW
#undef SLOAD
#undef SWRITE
#undef SWAIT
#undef RESC
}
#undef KSWZ
#undef SBAR
}

#define LAS __attribute__((address_space(3)))
#define GAS __attribute__((address_space(1)))
typedef unsigned short bf16;
typedef float f32x4 __attribute__((ext_vector_type(4)));
typedef unsigned u32x4 __attribute__((ext_vector_type(4)));
typedef unsigned u32x2 __attribute__((ext_vector_type(2)));

constexpr int D = 1024, NBATCH = 16, SEQ = 2048, CTXL = 256, DEPTH = 4;
constexpr int RL = NBATCH * SEQ, RC = NBATCH * CTXL, RT = RL + RC;
constexpr int DFF = 2816, NCOND = 17, MODW = 9 * D;
constexpr float EPS = 1e-6f;
constexpr float QSC = 0.07216878364870322f * 1.4426950408889634f;
constexpr int NWAVES = 8;
constexpr int LDS_BYTES = 147456;

enum { I_X = 0, I_C, I_CTX, I_CCTX, I_WMOD, I_BMOD, I_GNORM, I_W1, I_W3, I_W2, I_SCWIN, I_SCCONV, I_SCWOUT, I_WA, I_GQA, I_WUQ, I_GKVA, I_WUKV, I_GQ, I_GK, I_WO, N_IN };

constexpr size_t MiB = 1u << 20;
constexpr size_t OFF_MOD = 0;
constexpr size_t OFF_ROPE = 4 * MiB;
constexpr size_t OFF_STAT = 4 * MiB + 512 * 1024;
constexpr size_t OFF_CTL = 6 * MiB, CTL_BYTES = 65536;

constexpr size_t OFF_WUP = 8 * MiB;
constexpr size_t SZ_WUP = (size_t)5632 * 1024 * 2;
constexpr size_t OFF_WDN = 96 * MiB;
constexpr size_t SZ_WDN = (size_t)1024 * 2816 * 2;
constexpr size_t OFF_WIN = 140 * MiB;
constexpr size_t SZ_WIN = (size_t)3072 * 1024 * 2;
constexpr size_t OFF_WOUT = 152 * MiB;
constexpr size_t SZ_SQ = (size_t)1024 * 1024 * 2;
constexpr size_t OFF_WA = 156 * MiB;
constexpr size_t SZ_WA = (size_t)512 * 1024 * 2;
constexpr size_t OFF_WUQ = 158 * MiB;
constexpr size_t SZ_WUQ = (size_t)1536 * 256 * 2;
constexpr size_t OFF_WUKV = 160 * MiB;
constexpr size_t SZ_WUKV = (size_t)2048 * 128 * 2;
constexpr size_t OFF_WO = 160 * MiB + 2 * MiB;
constexpr size_t SZ_WO = (size_t)1024 * 1536 * 2;
constexpr size_t OFF_HCTX = 168 * MiB;
constexpr size_t OFF_NH = 184 * MiB;
constexpr size_t OFF_BIG = 256 * MiB;
constexpr size_t OFF_ACT = OFF_BIG;
constexpr size_t OFF_BB = OFF_BIG;
constexpr size_t OFF_VV = OFF_BIG + 72 * MiB;
constexpr size_t OFF_YY = OFF_BIG + 144 * MiB;
constexpr size_t OFF_CQKV = OFF_BIG;
constexpr size_t OFF_Q = OFF_BIG + 36 * MiB;
constexpr size_t OFF_K = OFF_BIG + 144 * MiB;
constexpr size_t OFF_V = OFF_BIG + 252 * MiB;
constexpr size_t OFF_BIAS = OFF_BIG + 324 * MiB;
constexpr size_t BIAS_UP = 0, BIAS_WIN = (size_t)8 * 17 * 5632, BIAS_WA = BIAS_WIN + (size_t)2 * 17 * 3072;
constexpr size_t OFF_SS = OFF_BIAS + 4 * MiB;
constexpr size_t WS_END = OFF_BIAS + 8 * MiB;

struct Params { const float* in[N_IN]; float* out; unsigned char* ws; int pad0, pad1; };
constexpr int MISC_OFF = LDS_BYTES - 512;
constexpr int PTAB_OFF = LDS_BYTES - 256, I_OUT = N_IN, I_WS = N_IN + 1;
__device__ __forceinline__ unsigned long long ldp_raw(int i) {
    volatile LAS unsigned* t = (volatile LAS unsigned*)(uintptr_t)PTAB_OFF;
    const unsigned lo = __builtin_amdgcn_readfirstlane(t[2 * i]), hi = __builtin_amdgcn_readfirstlane(t[2 * i + 1]);
    return ((unsigned long long)hi << 32) | lo;
}
__device__ __forceinline__ const float* ldp(int i) { return (const float*)ldp_raw(i); }
__device__ __forceinline__ unsigned char* ldws() { return (unsigned char*)ldp_raw(I_WS); }

__device__ __forceinline__ float wave_sum(float v) {
#pragma unroll
    for (int o = 1; o < 64; o <<= 1) v += __shfl_xor(v, o);
    return v;
}
__device__ __forceinline__ float wave_sum_dpp(float v) {
    v += __builtin_bit_cast(float, __builtin_amdgcn_mov_dpp(__builtin_bit_cast(int, v), 0xB1, 0xf, 0xf, false));
    v += __builtin_bit_cast(float, __builtin_amdgcn_mov_dpp(__builtin_bit_cast(int, v), 0x4E, 0xf, 0xf, false));
    v += __builtin_bit_cast(float, __builtin_amdgcn_mov_dpp(__builtin_bit_cast(int, v), 0x141, 0xf, 0xf, false));
    v += __builtin_bit_cast(float, __builtin_amdgcn_mov_dpp(__builtin_bit_cast(int, v), 0x140, 0xf, 0xf, false));
    return pg8::xrow_sum(v);
}
__device__ __forceinline__ unsigned f2bf(float f) { unsigned u = __builtin_bit_cast(unsigned, f); return (u + 0x7fffu + ((u >> 16) & 1u)) >> 16; }
__device__ __forceinline__ unsigned pk2(float lo, float hi) { unsigned r; asm("v_cvt_pk_bf16_f32 %0, %1, %2" : "=v"(r) : "v"(lo), "v"(hi)); return r; }
__device__ __forceinline__ float bf_lo(unsigned w) { return __builtin_bit_cast(float, w << 16); }
__device__ __forceinline__ float bf_hi(unsigned w) { return __builtin_bit_cast(float, w & 0xffff0000u); }

__device__ __forceinline__ void transpose_item(const float* W, int K, int N, bf16* WT, int Kd, int mode, const float* kscale, LAS float* scr, int item, int lane) {
    const int nblk = N / 32, kb = item / nblk, nb = item % nblk, k0 = 64 * kb, n0 = 32 * nb;
    float tv[32];
#pragma unroll
    for (int i = 0; i < 32; ++i) { const int kk = 2 * i + (lane >> 5); tv[i] = W[(size_t)(k0 + kk) * N + n0 + (lane & 31)]; }
#pragma unroll
    for (int i = 0; i < 32; ++i) { const int kk = 2 * i + (lane >> 5); scr[kk * 33 + (lane & 31)] = tv[i]; }
    asm volatile("s_waitcnt lgkmcnt(0)" ::: "memory");
    int r0;
    if (mode == 0) r0 = n0;
    else if (mode == 1) r0 = 256 * (n0 >> 7) + (n0 & 127);
    else if (mode == 2) r0 = 256 * (n0 >> 7) + 128 + (n0 & 127);
    else { if (n0 < 1024) r0 = n0; else if (n0 < 2048) { const int c = n0 - 1024; r0 = 1024 + 256 * (c >> 7) + (c & 127); } else { const int c = n0 - 2048; r0 = 1024 + 256 * (c >> 7) + 128 + (c & 127); } }
    const int c = lane & 7; const int kd0 = (mode == 4) ? 192 * (k0 >> 7) + (k0 & 127) : k0;
    float ks[8];
#pragma unroll
    for (int q = 0; q < 8; ++q) ks[q] = kscale ? kscale[k0 + 8 * c + q] : 1.0f;
#pragma unroll
    for (int j = 0; j < 4; ++j) { const int n = (lane >> 3) + 8 * j; const LAS float* s = scr + (8 * c) * 33 + n;
        u32x4 o; o.x = pk2(s[0 * 33] * ks[0], s[1 * 33] * ks[1]); o.y = pk2(s[2 * 33] * ks[2], s[3 * 33] * ks[3]); o.z = pk2(s[4 * 33] * ks[4], s[5 * 33] * ks[5]); o.w = pk2(s[6 * 33] * ks[6], s[7 * 33] * ks[7]);
        *(u32x4*)(WT + (size_t)(r0 + n) * Kd + kd0 + 8 * c) = o; }
    asm volatile("s_waitcnt lgkmcnt(0)" ::: "memory");
}

constexpr int IT_FFN = 1408;
constexpr int IT_A0 = 0, IT_B0 = IT_A0 + 8 * IT_FFN, IT_C0 = IT_B0 + 8 * IT_FFN, IT_D0 = IT_C0 + 8 * IT_FFN;
constexpr int IT_WIN = 16 * 96, IT_SQ = 16 * 32, IT_WA = 16 * 14, IT_WUQ = 4 * 48, IT_WUKV = 2 * 64;
constexpr int IT_E0 = IT_D0 + 2 * IT_WIN, IT_F0 = IT_E0 + 2 * IT_SQ, IT_G0 = IT_F0 + 2 * IT_SQ, IT_H0 = IT_G0 + 2 * IT_WA, IT_I0 = IT_H0 + 2 * IT_WUQ, IT_END = IT_I0 + 2 * IT_WUKV;

__device__ __forceinline__ void convert_item(int it, LAS float* scr, int lane) {
    unsigned char* ws = ldws();
    if (it < IT_B0) { const int m = it / IT_FFN, r = it % IT_FFN; transpose_item(ldp(I_W1) + (size_t)m * D * DFF, D, DFF, (bf16*)(ws + OFF_WUP + m * SZ_WUP), D, 1, nullptr, scr, r, lane); return; }
    if (it < IT_C0) { it -= IT_B0; const int m = it / IT_FFN, r = it % IT_FFN; transpose_item(ldp(I_W3) + (size_t)m * D * DFF, D, DFF, (bf16*)(ws + OFF_WUP + m * SZ_WUP), D, 2, nullptr, scr, r, lane); return; }
    if (it < IT_D0) { it -= IT_C0; const int m = it / IT_FFN, r = it % IT_FFN; transpose_item(ldp(I_W2) + (size_t)m * DFF * D, DFF, D, (bf16*)(ws + OFF_WDN + m * SZ_WDN), DFF, 0, nullptr, scr, r, lane); return; }
    if (it < IT_E0) { it -= IT_D0; const int m = it / IT_WIN, r = it % IT_WIN; transpose_item(ldp(I_SCWIN) + (size_t)m * D * 3072, D, 3072, (bf16*)(ws + OFF_WIN + m * SZ_WIN), D, 3, nullptr, scr, r, lane); return; }
    if (it < IT_F0) { it -= IT_E0; const int m = it / IT_SQ, r = it % IT_SQ; transpose_item(ldp(I_SCWOUT) + (size_t)m * D * D, D, D, (bf16*)(ws + OFF_WOUT + m * SZ_SQ), D, 0, nullptr, scr, r, lane); return; }
    if (it < IT_G0) { it -= IT_F0; const int m = it / IT_SQ, r = it % IT_SQ; transpose_item(ldp(I_WO) + (size_t)m * D * D, D, D, (bf16*)(ws + OFF_WO + m * SZ_WO), 1536, 4, nullptr, scr, r, lane); return; }
    if (it < IT_H0) { it -= IT_G0; const int m = it / IT_WA, r = it % IT_WA; transpose_item(ldp(I_WA) + (size_t)m * D * 448, D, 448, (bf16*)(ws + OFF_WA + m * SZ_WA), D, 0, nullptr, scr, r, lane); return; }
    if (it < IT_I0) { it -= IT_H0; const int m = it / IT_WUQ, r = it % IT_WUQ; transpose_item(ldp(I_WUQ) + (size_t)m * 256 * 1536, 256, 1536, (bf16*)(ws + OFF_WUQ + m * SZ_WUQ), 256, 0, ldp(I_GQA) + m * 256, scr, r, lane); return; }
    { it -= IT_I0; const int m = it / IT_WUKV, r = it % IT_WUKV; transpose_item(ldp(I_WUKV) + (size_t)m * 128 * 2048, 128, 2048, (bf16*)(ws + OFF_WUKV + m * SZ_WUKV), 128, 0, ldp(I_GKVA) + m * 128, scr, r, lane); }
}

__device__ __forceinline__ void mod_group(int grp, LAS unsigned char* lds, int tid, int wave, int lane) {
    LAS float* S = (LAS float*)lds;
    const float* cin = ldp(I_C); const float* cctx = ldp(I_CCTX);
    for (int i = tid; i < NCOND * 1024; i += 512) { const int c = i >> 10, k = i & 1023; const float v = c < 16 ? cin[c * 1024 + k] : cctx[k]; S[i] = v / (1.0f + __expf(-v)); }
    __syncthreads();
    const int l = grp / 36, cg0 = (grp % 36) * 256;
    const float* W = ldp(I_WMOD) + (size_t)l * 1024 * MODW + cg0 + lane * 4;
    const int kbase = wave * 128;
    f32x4 acc[NCOND];
#pragma unroll
    for (int c = 0; c < NCOND; ++c) acc[c] = (f32x4){0.f, 0.f, 0.f, 0.f};
    for (int kk = 0; kk < 128; kk += 4) {
        const float* wp = W + (size_t)(kbase + kk) * MODW;
        const f32x4 w0 = *(const f32x4*)(wp), w1 = *(const f32x4*)(wp + MODW), w2 = *(const f32x4*)(wp + 2 * MODW), w3 = *(const f32x4*)(wp + 3 * MODW);
#pragma unroll
        for (int c = 0; c < NCOND; ++c) { const f32x4 s = *(const LAS f32x4*)(S + c * 1024 + kbase + kk); acc[c] += w0 * s.x + w1 * s.y + w2 * s.z + w3 * s.w; }
    }
    __syncthreads();
    LAS float* P = (LAS float*)lds;
#pragma unroll
    for (int c = 0; c < NCOND; ++c) *(LAS f32x4*)(P + (wave * NCOND + c) * 256 + lane * 4) = acc[c];
    __syncthreads();
    float* MOD = (float*)(ldws() + OFF_MOD); const float* bmod = ldp(I_BMOD);
    for (int o = tid; o < NCOND * 256; o += 512) { const int c = o >> 8, col = o & 255; float s = bmod[l * MODW + cg0 + col];
#pragma unroll
        for (int w = 0; w < 8; ++w) s += P[(w * NCOND + c) * 256 + col];
        MOD[(size_t)(l * NCOND + c) * MODW + cg0 + col] = s; }
    __syncthreads();
}

__device__ __forceinline__ void norm_phase(const float* hl, const float* hc, const float* g, const float* modl, int chunk, bf16* NH, int nrows, int gw, int NGW, int lane) {
    for (int row = gw; row < nrows; row += NGW) {
        const float* src = row < RL ? hl + (size_t)row * D : hc + (size_t)(row - RL) * D;
        const int cond = row < RL ? (row >> 11) : 16;
        const float* sh = modl + (size_t)cond * MODW + chunk * D; const float* sc = sh + D;
        f32x4 v[4]; float s = 0.f;
#pragma unroll
        for (int j = 0; j < 4; ++j) { v[j] = ((const f32x4*)src)[lane + 64 * j]; s += (v[j].x * v[j].x + v[j].y * v[j].y) + (v[j].z * v[j].z + v[j].w * v[j].w); }
        const float rstd = rsqrtf(wave_sum(s) * (1.0f / D) + EPS);
        u32x2* o8 = (u32x2*)(NH + (size_t)row * D) + lane;
#pragma unroll
        for (int j = 0; j < 4; ++j) { const f32x4 gg = ((const f32x4*)g)[lane + 64 * j], ss = ((const f32x4*)sc)[lane + 64 * j], hh = ((const f32x4*)sh)[lane + 64 * j];
            const f32x4 y = v[j] * rstd * gg * (ss + 1.0f) + hh; u32x2 w; w.x = pk2(y.x, y.y); w.y = pk2(y.z, y.w); o8[64 * j] = w; }
    }
}


__device__ __forceinline__ void bias_unit(int unit, LAS unsigned char* lds, int tid, int wave, int lane) {
    unsigned char* ws = ldws(); const float* MOD = (const float*)(ws + OFF_MOD); float* BIAS = (float*)(ws + OFF_BIAS);
    int l, chunk, N, row0; const bf16* Bt; float* out;
    if (unit < 352) { const int m = unit / 44; l = m >> 1; chunk = (m & 1) ? 6 : 0; N = 5632; row0 = (unit % 44) * 128; Bt = (const bf16*)(ws + OFF_WUP + m * SZ_WUP); out = BIAS + BIAS_UP + (size_t)m * 17 * 5632; }
    else if (unit < 400) { const int j = (unit - 352) / 24; l = 2 * j; chunk = 3; N = 3072; row0 = ((unit - 352) % 24) * 128; Bt = (const bf16*)(ws + OFF_WIN + j * SZ_WIN); out = BIAS + BIAS_WIN + (size_t)j * 17 * 3072; }
    else { const int j = (unit - 400) / 4; l = 2 * j + 1; chunk = 3; N = 512; row0 = ((unit - 400) % 4) * 128; Bt = (const bf16*)(ws + OFF_WA + j * SZ_WA); out = BIAS + BIAS_WA + (size_t)j * 17 * 512; }
    LAS float* S = (LAS float*)lds;
    __syncthreads();
    for (int i = tid * 4; i < NCOND * 1024; i += 2048) { const int c = i >> 10, k = i & 1023; *(LAS f32x4*)(S + i) = *(const GAS f32x4*)(MOD + (size_t)(l * NCOND + c) * MODW + chunk * D + k); }
    __syncthreads();
    for (int r = 0; r < 16; ++r) { const int n = row0 + wave * 16 + r;
        float w[16];
#pragma unroll
        for (int q = 0; q < 4; ++q) { const u32x2 v = *(const u32x2*)(Bt + (size_t)n * D + 256 * q + 4 * lane); w[4 * q] = bf_lo(v.x); w[4 * q + 1] = bf_hi(v.x); w[4 * q + 2] = bf_lo(v.y); w[4 * q + 3] = bf_hi(v.y); }
        float mine = 0.f;
#pragma unroll
        for (int c = 0; c < NCOND; ++c) { float a = 0.f;
#pragma unroll
            for (int q = 0; q < 4; ++q) { const f32x4 sv = *(const LAS f32x4*)(S + c * 1024 + 256 * q + 4 * lane); a += sv.x * w[4 * q] + sv.y * w[4 * q + 1] + sv.z * w[4 * q + 2] + sv.w * w[4 * q + 3]; }
            a = wave_sum_dpp(a); mine = (lane == c) ? a : mine; }
        if (lane < NCOND) out[(size_t)lane * N + n] = mine;
    }
}
__device__ __forceinline__ void first_aprime(const float* xl, const float* xc, const float* g, const float* sc0, bf16* NH, float* SS, int gw, int NGW, int lane) {
    for (int row0 = gw; row0 < RT; row0 += 4 * NGW) {
        f32x4 v[4][4];
#pragma unroll
        for (int q = 0; q < 4; ++q) { const int row = (row0 + q * NGW < RT) ? row0 + q * NGW : row0; const float* src = row < RL ? xl + (size_t)row * D : xc + (size_t)(row - RL) * D;
#pragma unroll
            for (int j = 0; j < 4; ++j) v[q][j] = ((const f32x4*)src)[lane + 64 * j]; }
#pragma unroll
        for (int q = 0; q < 4; ++q) { const int row = row0 + q * NGW; if (row < RT) {
            const int cond = row < RL ? (row >> 11) : 16; const float* sc = sc0 + (size_t)cond * MODW; float s = 0.f;
#pragma unroll
            for (int j = 0; j < 4; ++j) s += (v[q][j].x * v[q][j].x + v[q][j].y * v[q][j].y) + (v[q][j].z * v[q][j].z + v[q][j].w * v[q][j].w);
            s = wave_sum_dpp(s); if (lane < 16) SS[(size_t)row * 16 + lane] = (lane == 0) ? s : 0.f;
            u32x2* o8 = (u32x2*)(NH + (size_t)row * D) + lane;
#pragma unroll
            for (int j = 0; j < 4; ++j) { const f32x4 gg = ((const f32x4*)g)[lane + 64 * j], ss = ((const f32x4*)sc)[lane + 64 * j];
                const f32x4 y = v[q][j] * gg * (ss + 1.0f); u32x2 w; w.x = pk2(y.x, y.y); w.y = pk2(y.z, y.w); o8[64 * j] = w; } } }
    }
}


__device__ __forceinline__ void ctx_fix(const float* hin, float* hout, const float* part, const float* gate16, float gs, bf16* NHc, float* SSc_, const float* gn, const float* sc16, int gw, int NGW, int lane) {
    for (int r = gw; r < RC; r += NGW) {
        const GAS f32x4* hp = (const GAS f32x4*)(hin + (size_t)r * D) + lane; GAS f32x4* op = (GAS f32x4*)(hout + (size_t)r * D) + lane;
        f32x4 h[4], p[4][4];
#pragma unroll
        for (int j = 0; j < 4; ++j) { h[j] = hp[64 * j];
#pragma unroll
            for (int q = 0; q < 4; ++q) { const u32x2 w_ = ((const GAS u32x2*)((const bf16*)part + ((size_t)q * RC + r) * D) + lane)[64 * j]; p[q][j] = (f32x4){bf_lo(w_.x), bf_hi(w_.x), bf_lo(w_.y), bf_hi(w_.y)}; } }
        float sq = 0.f; f32x4 o[4];
#pragma unroll
        for (int j = 0; j < 4; ++j) { const f32x4 gg = ((const f32x4*)gate16)[lane + 64 * j] * gs; o[j] = h[j] + gg * (((p[0][j] + p[1][j]) + p[2][j]) + p[3][j]); op[64 * j] = o[j];
            sq += (o[j].x * o[j].x + o[j].y * o[j].y) + (o[j].z * o[j].z + o[j].w * o[j].w); }
        if (gn) {
            sq = wave_sum_dpp(sq); if (lane < 16) SSc_[(size_t)(RL + r) * 16 + lane] = (lane == 0) ? sq : 0.f;
            GAS u32x2* a8 = (GAS u32x2*)(NHc + (size_t)(RL + r) * D) + lane;
#pragma unroll
            for (int j = 0; j < 4; ++j) { const f32x4 y = o[j] * ((const f32x4*)gn)[lane + 64 * j] * (((const f32x4*)sc16)[lane + 64 * j] + 1.0f); u32x2 w; w.x = pk2(y.x, y.y); w.y = pk2(y.z, y.w); a8[64 * j] = w; }
        }
    }
}

__device__ __forceinline__ void stats_phase(const bf16* CQKV, float* rq, float* rkv, int gw, int NGW, int lane) {
    for (int row = gw; row < RT; row += NGW) {
        const u32x2 a = *((const u32x2*)(CQKV + (size_t)row * 512) + lane);
        float sq = bf_lo(a.x) * bf_lo(a.x) + bf_hi(a.x) * bf_hi(a.x) + bf_lo(a.y) * bf_lo(a.y) + bf_hi(a.y) * bf_hi(a.y);
        float sk = 0.f;
        if (lane < 32) { const u32x2 b = *((const u32x2*)(CQKV + (size_t)row * 512 + 256) + lane); sk = bf_lo(b.x) * bf_lo(b.x) + bf_hi(b.x) * bf_hi(b.x) + bf_lo(b.y) * bf_lo(b.y) + bf_hi(b.y) * bf_hi(b.y); }
        sq = wave_sum_dpp(sq); sk = wave_sum(sk);
        if (lane == 0) { rq[row] = rsqrtf(sq * (1.0f / 256.0f) + EPS); rkv[row] = rsqrtf(sk * (1.0f / 128.0f) + EPS); }
    }
}

__device__ __forceinline__ void unpack8(const u32x4 w, float* x) { x[0] = bf_lo(w.x); x[1] = bf_hi(w.x); x[2] = bf_lo(w.y); x[3] = bf_hi(w.y); x[4] = bf_lo(w.z); x[5] = bf_hi(w.z); x[6] = bf_lo(w.w); x[7] = bf_hi(w.w); }
__device__ __forceinline__ float dpp_xor1(float v) { return __builtin_bit_cast(float, __builtin_amdgcn_mov_dpp(__builtin_bit_cast(int, v), 0xB1, 0xf, 0xf, false)); }
__device__ __forceinline__ float dpp_xor2(float v) { return __builtin_bit_cast(float, __builtin_amdgcn_mov_dpp(__builtin_bit_cast(int, v), 0x4E, 0xf, 0xf, false)); }
__device__ __forceinline__ float dpp_hmirror(float v) { return __builtin_bit_cast(float, __builtin_amdgcn_mov_dpp(__builtin_bit_cast(int, v), 0x141, 0xf, 0xf, false)); }
__device__ __forceinline__ void qk_fin8(const u32x4 (&w)[3], const float (&g)[3][8], const float* cs, const float* sn, bool rope, bool second, float outscale, u32x4 (&o)[3]) {
    float x[3][8]; float ss = 0.f;
#pragma unroll
    for (int j = 0; j < 3; ++j) { unpack8(w[j], x[j]);
#pragma unroll
        for (int i = 0; i < 8; ++i) ss += x[j][i] * x[j][i]; }
    ss += dpp_xor1(ss); ss += dpp_xor2(ss); ss += dpp_hmirror(ss);
    const float r = rsqrtf(ss * (1.0f / 192.0f) + EPS);
#pragma unroll
    for (int j = 0; j < 3; ++j)
#pragma unroll
        for (int i = 0; i < 8; ++i) x[j][i] = x[j][i] * r * g[j][i];
    float pr[8];
#pragma unroll
    for (int i = 0; i < 8; ++i) pr[i] = dpp_xor2(x[2][i]);
    if (rope) {
#pragma unroll
        for (int i = 0; i < 8; ++i) x[2][i] = second ? (pr[i] * sn[i] + x[2][i] * cs[i]) : (x[2][i] * cs[i] - pr[i] * sn[i]);
    }
#pragma unroll
    for (int j = 0; j < 3; ++j) { o[j].x = pk2(x[j][0] * outscale, x[j][1] * outscale); o[j].y = pk2(x[j][2] * outscale, x[j][3] * outscale); o[j].z = pk2(x[j][4] * outscale, x[j][5] * outscale); o[j].w = pk2(x[j][6] * outscale, x[j][7] * outscale); }
}
__device__ __forceinline__ void finalize_phase(bf16* Qb_, bf16* Kb_, const bf16* CQKV_, const float* gq, const float* gk, const float* ropetab, bool need_qc, int gw, int NGW, int lane) {
    GAS bf16* Kb = (GAS bf16*)Kb_; const GAS bf16* CQKV = (const GAS bf16*)CQKV_; const GAS float* rt = (const GAS float*)ropetab;
    const int l8 = lane & 7, head = lane >> 3;
    float gkv[3][8];
#pragma unroll
    for (int j = 0; j < 3; ++j)
#pragma unroll
        for (int i = 0; i < 8; ++i) gkv[j][i] = gk[(l8 + 8 * j) * 8 + i];
    const int axis = (l8 >= 4) ? 1 : 0, f0 = 8 * (l8 & 1); const bool second = (l8 & 2) != 0;
    for (int row0 = gw; row0 < RT; row0 += 4 * NGW) {
        u32x4 kw[4][3]; f32x4 cc[4][4];
#pragma unroll
        for (int q = 0; q < 4; ++q) { const int row = (row0 + q * NGW < RT) ? row0 + q * NGW : row0; const int t = row < RL ? (row & (SEQ - 1)) : 0;
            const GAS float* ct = rt + ((size_t)t * 2 + axis) * 16 + f0; const size_t o0 = (size_t)row * 1536 + head * 192 + l8 * 8;
            cc[q][0] = *(const GAS f32x4*)ct; cc[q][1] = *(const GAS f32x4*)(ct + 4); cc[q][2] = *(const GAS f32x4*)(ct + SEQ * 32); cc[q][3] = *(const GAS f32x4*)(ct + SEQ * 32 + 4);
            kw[q][0] = *(const GAS u32x4*)(Kb + o0); kw[q][1] = *(const GAS u32x4*)(Kb + o0 + 64); kw[q][2] = *(const GAS u32x4*)(CQKV + (size_t)row * 512 + 384 + l8 * 8); }
#pragma unroll
        for (int q = 0; q < 4; ++q) { const int row = row0 + q * NGW; if (row < RT) {
            const float cs[8] = {cc[q][0].x, cc[q][0].y, cc[q][0].z, cc[q][0].w, cc[q][1].x, cc[q][1].y, cc[q][1].z, cc[q][1].w}, sn[8] = {cc[q][2].x, cc[q][2].y, cc[q][2].z, cc[q][2].w, cc[q][3].x, cc[q][3].y, cc[q][3].z, cc[q][3].w};
            u32x4 ov[3]; qk_fin8(kw[q], gkv, cs, sn, row < RL, second, 1.0f, ov);
            const size_t o0 = (size_t)row * 1536 + head * 192 + l8 * 8;
#pragma unroll
            for (int j = 0; j < 3; ++j) *(GAS u32x4*)(Kb + o0 + 64 * j) = ov[j]; } }
    }
}

__device__ __forceinline__ void conv_phase(const bf16* Bb_, const bf16* Vb_, const float* cw, bf16* Y_, int gtid, int NT_) {
    const GAS bf16* Bb = (const GAS bf16*)Bb_; const GAS bf16* Vb = (const GAS bf16*)Vb_; GAS bf16* Y = (GAS bf16*)Y_;
    const int c8 = (gtid & 127) * 8;
    float w0[8], w1[8], w2[8];
#pragma unroll
    for (int i = 0; i < 8; ++i) { w0[i] = cw[c8 + i]; w1[i] = cw[D + c8 + i]; w2[i] = cw[2 * D + c8 + i]; }
    for (int it0 = gtid; it0 < RT * 128; it0 += 4 * NT_) {
        u32x4 lb[4], l0[4], l1[4], l2[4]; float m0[4], m2[4];
#pragma unroll
        for (int q = 0; q < 4; ++q) { const int it = (it0 + q * NT_ < RT * 128) ? it0 + q * NT_ : it0;
            const int row = it >> 7;
            const int pos = row < RL ? (row & (SEQ - 1)) : ((row - RL) & (CTXL - 1)); const int len = row < RL ? SEQ : CTXL;
            const size_t off = (size_t)row * D + c8; const bool hp = pos > 0, hn = pos < len - 1;
            lb[q] = *(const GAS u32x4*)(Bb + off); l1[q] = *(const GAS u32x4*)(Vb + off);
            l0[q] = *(const GAS u32x4*)(Vb + (hp ? off - D : off)); l2[q] = *(const GAS u32x4*)(Vb + (hn ? off + D : off));
            m0[q] = hp ? 1.f : 0.f; m2[q] = hn ? 1.f : 0.f; }
#pragma unroll
        for (int q = 0; q < 4; ++q) { const int it = it0 + q * NT_; if (it < RT * 128) {
            const int row = it >> 7; const size_t off = (size_t)row * D + c8;
            float b[8], v0[8], v1[8], v2[8], y[8];
            unpack8(lb[q], b); unpack8(l0[q], v0); unpack8(l1[q], v1); unpack8(l2[q], v2);
#pragma unroll
            for (int i = 0; i < 8; ++i) y[i] = b[i] * (w0[i] * m0[q] * v0[i] + w1[i] * v1[i] + w2[i] * m2[q] * v2[i]);
            u32x4 o; o.x = pk2(y[0], y[1]); o.y = pk2(y[2], y[3]); o.z = pk2(y[4], y[5]); o.w = pk2(y[6], y[7]);
            *(GAS u32x4*)(Y + off) = o; } }
    }
}

#define XB_TMO      128
#define XB_XCNT(j)  (256  + 64 * (j))
#define XB_XSUB(j)  (1280 + 64 * (j))
#define XB_XGEN(j)  (2304 + 64 * (j))
#define XB_TOP      3328
#define XB_TOPGEN   3392
#define XCD_BAR_WORDS 3456
#define XB_SPIN_CAP (1u << 18)

__device__ __forceinline__ unsigned xb_ld(unsigned* p)              { return __hip_atomic_load(p, __ATOMIC_RELAXED, __HIP_MEMORY_SCOPE_AGENT); }
__device__ __forceinline__ unsigned xb_add(unsigned* p, unsigned v) { return __hip_atomic_fetch_add(p, v, __ATOMIC_RELAXED, __HIP_MEMORY_SCOPE_AGENT); }
__device__ __forceinline__ unsigned xb_xcc_id() { return (unsigned)__builtin_amdgcn_s_getreg((3 << 11) | 20) & 0xFu; }
#define XB_SPIN(cond, bar) do { unsigned _sp = 0; while (cond) { __builtin_amdgcn_s_sleep(1); \
    if ((++_sp & 255u) == 0u) { if (xb_ld(&(bar)[XB_TMO])) break; if (_sp > XB_SPIN_CAP) { atomicAdd(&(bar)[XB_TMO], 1u); break; } } } } while (0)

struct XcdBarrier {
    unsigned* bar; unsigned x;
    volatile LAS unsigned* st;
};

__device__ __forceinline__ XcdBarrier xcd_barrier_post(unsigned* bar, volatile LAS unsigned* st) {
    XcdBarrier b; b.bar = bar; b.x = xb_xcc_id(); b.st = st;
    if (threadIdx.x == 0) (void)xb_add(&bar[XB_XCNT(b.x)], 1u);
    return b;
}
__device__ __forceinline__ void xcd_barrier_complete(unsigned* bar, unsigned x, unsigned& nloc, unsigned& nx) {
    const unsigned G = gridDim.x * gridDim.y * gridDim.z;
    unsigned sum, cnt, mine, sp = 0u;
    for (;;) {
        sum = 0u; cnt = 0u; mine = 0u;
#pragma unroll
        for (unsigned j = 0; j < 16; ++j) { const unsigned c = xb_ld(&bar[XB_XCNT(j)]); sum += c; cnt += (c > 0u) ? 1u : 0u; mine = (j == x) ? c : mine; }
        if (sum == G) break;
        __builtin_amdgcn_s_sleep(1);
        if ((++sp & 255u) == 0u) { if (xb_ld(&bar[XB_TMO])) break; if (sp > XB_SPIN_CAP) { atomicAdd(&bar[XB_TMO], 1u); break; } }
    }
    nloc = mine > 0u ? mine : 1u; nx = cnt > 0u ? cnt : 1u;
}

__device__ __forceinline__ void xcd_barrier(const XcdBarrier& b) {
    asm volatile("s_waitcnt vmcnt(0)" ::: "memory");
    __syncthreads();
    if (threadIdx.x == 0) {
        unsigned* bar = b.bar;
        __builtin_amdgcn_s_waitcnt(0);
        unsigned nloc = b.st[0], nx = b.st[1];
        if (nloc == 0u) { xcd_barrier_complete(bar, b.x, nloc, nx); b.st[0] = nloc; b.st[1] = nx; }
        const unsigned old = xb_add(&bar[XB_XSUB(b.x)], 1u);
        const unsigned gen = old / nloc;
        if (old + 1u == (gen + 1u) * nloc) {
            __builtin_amdgcn_fence(__ATOMIC_RELEASE, "agent");
            asm volatile("s_waitcnt vmcnt(0)" ::: "memory");
            const unsigned og = xb_add(&bar[XB_TOP], 1u);
            const unsigned tg = og / nx;
            if (og + 1u == (tg + 1u) * nx) xb_add(&bar[XB_TOPGEN], 1u);
            else XB_SPIN(xb_ld(&bar[XB_TOPGEN]) == tg, bar);
            __builtin_amdgcn_fence(__ATOMIC_ACQUIRE, "agent");
            xb_add(&bar[XB_XGEN(b.x)], 1u);
            asm volatile("s_waitcnt vmcnt(0)" ::: "memory");
        } else {
            XB_SPIN(xb_ld(&bar[XB_XGEN(b.x)]) == gen, bar);
            __builtin_amdgcn_fence(__ATOMIC_ACQUIRE, "agent");
            asm volatile("s_waitcnt vmcnt(0)" ::: "memory");
        }
    }
    __syncthreads();
}


typedef pg8::GemmT<D, DFF, DFF> GemmDn; typedef pg8::GemmT<D, D, D> GemmSq; typedef pg8::GemmT<D, 1536, 1536> GemmWo;
#define GSYNC() do { XcdBarrier b_; b_.bar = (unsigned*)(ldws() + OFF_CTL); b_.x = xb_xcc_id(); b_.st = (volatile LAS unsigned*)(uintptr_t)MISC_OFF; xcd_barrier(b_); } while (0)
__global__ void __launch_bounds__(NWAVES * 64) fwd_megakernel(Params p) {
    extern __shared__ __attribute__((aligned(16))) unsigned char lds_raw[];
    cg::grid_group grid = cg::this_grid();
    LAS unsigned char* lds = (LAS unsigned char*)lds_raw;
    const int tid = threadIdx.x, lane = tid & 63, wave = __builtin_amdgcn_readfirstlane(tid >> 6);
    if (tid == 0) {
        volatile LAS unsigned long long* t = (volatile LAS unsigned long long*)(uintptr_t)PTAB_OFF;
#pragma unroll
        for (int i = 0; i < N_IN; ++i) t[i] = (unsigned long long)p.in[i];
        t[I_OUT] = (unsigned long long)p.out; t[I_WS] = (unsigned long long)p.ws;
        volatile LAS unsigned* m = (volatile LAS unsigned*)(uintptr_t)MISC_OFF; m[0] = 0u; m[1] = 0u;
    }
    __syncthreads();
    (void)xcd_barrier_post((unsigned*)(p.ws + OFF_CTL), (volatile LAS unsigned*)(uintptr_t)MISC_OFF);
    if (p.pad0 != 0) grid.sync();
#define BX() ({ int b_ = blockIdx.x; asm volatile("" : "+s"(b_)); b_; })
#define GD() ({ int g_ = gridDim.x; asm volatile("" : "+s"(g_)); g_; })
#define GW (BX() * NWAVES + wave)
#define NGW_ (GD() * NWAVES)

    {
        const int G = GD(), bx = BX();
#ifndef NO_MOD
        for (int g = bx; g < 144; g += G) mod_group(g, lds, tid, wave, lane);
#endif
        unsigned char* ws = ldws(); float* ROPE = (float*)(ws + OFF_ROPE);
        for (int i = bx * 512 + tid; i < SEQ * 32; i += G * 512) { const int t = i >> 5, axis = (i >> 4) & 1, f = i & 15; const float pos = (float)(axis ? (t & 63) : (t >> 6));
            const float inv = exp2f(-(float)f * (13.287712379549449f / 16.0f)); const float a = pos * inv; ROPE[i] = cosf(a); ROPE[SEQ * 32 + i] = sinf(a); }
        for (int i = bx * 512 + tid; i < 2 * 64 * 128; i += G * 512) { const int j = i / (64 * 128), r = (i / 128) % 64, c = i % 128; *(u32x4*)((bf16*)(ws + OFF_WA + j * SZ_WA) + (size_t)(448 + r) * 1024 + c * 8) = (u32x4){0u, 0u, 0u, 0u}; }
        for (int i = bx * 512 + tid; i < 2 * 1024 * 64; i += G * 512) { const int j = i >> 16, r = (i >> 6) & 1023, h = (i >> 3) & 7, c = i & 7; *(u32x4*)((bf16*)(ws + OFF_WO + j * SZ_WO) + (size_t)r * 1536 + h * 192 + 128 + c * 8) = (u32x4){0u, 0u, 0u, 0u}; }
        LAS float* scr = (LAS float*)(lds + wave * 16384);
        for (int it = GW; it < IT_END; it += NGW_) convert_item(it, scr, lane);
    }
    GSYNC();
    {
        int tidv = threadIdx.x; asm volatile("" : "+v"(tidv));
        const int tid2 = tidv, lane2 = tid2 & 63, wave2 = __builtin_amdgcn_readfirstlane(tid2 >> 6);
        for (int u = BX(); u < 408; u += GD()) bias_unit(u, lds, tid2, wave2, lane2);
        unsigned char* ws = ldws();
        first_aprime(ldp(I_X), ldp(I_CTX), ldp(I_GNORM), (const float*)(ws + OFF_MOD) + D, (bf16*)(ws + OFF_NH), (float*)(ws + OFF_SS), BX() * NWAVES + wave2, NGW_, lane2);
    }
    GSYNC();

#pragma unroll 1
    for (int it = 0; it < 3 * DEPTH; ++it) {
        {
            int itv = it; asm volatile("" : "+s"(itv));
            int tidv = threadIdx.x; asm volatile("" : "+v"(tidv));
            const int tid = tidv, lane = tid & 63, wave = __builtin_amdgcn_readfirstlane(tid >> 6);
            const int l = itv / 3, s = itv - 3 * l;
            const int kind = l & 1, j = l >> 1; const bool last = (l == DEPTH - 1);
            unsigned char* const ws = ldws();
            const int rows_out = (last && s >= 1) ? RL : RT;
            const float* SSc = (const float*)(ws + OFF_SS);
            if (s != 1) {
                const int m = l * 2 + (s >> 1);
                pg8::GemmT<2 * DFF, D, D> g{(const bf16*)(ws + OFF_NH), (const bf16*)(ws + OFF_WUP + m * SZ_WUP), rows_out}; pg8::StaticOrder S; S.init(rows_out, 2 * DFF, GD(), BX());
                pg8::EpiSwiGLU E{(bf16*)(ws + OFF_ACT), DFF, SSc, (const float*)(ws + OFF_BIAS) + BIAS_UP + (size_t)m * 17 * 5632};
                pg8::gemm_phase<pg8::EpiSwiGLU, pg8::StaticOrder, true, true>(lds, g, S, E);
                GSYNC();
            } else if (kind == 0) {
                { pg8::GemmT<3072, D, D> g{(const bf16*)(ws + OFF_NH), (const bf16*)(ws + OFF_WIN + j * SZ_WIN), rows_out}; pg8::StaticOrder S; S.init(rows_out, 3072, GD(), BX());
                  pg8::EpiWin E{(bf16*)(ws + OFF_BB), (bf16*)(ws + OFF_VV), SSc, (const float*)(ws + OFF_BIAS) + BIAS_WIN + (size_t)j * 17 * 3072};
                  pg8::gemm_phase<pg8::EpiWin, pg8::StaticOrder, true, true>(lds, g, S, E); }
                GSYNC();
                { conv_phase((const bf16*)(ws + OFF_BB), (const bf16*)(ws + OFF_VV), ldp(I_SCCONV) + (size_t)j * 3 * D, (bf16*)(ws + OFF_YY), BX() * 512 + tid, GD() * 512); }
                GSYNC();
            } else {
                { pg8::GemmT<512, D, D> g{(const bf16*)(ws + OFF_NH), (const bf16*)(ws + OFF_WA + j * SZ_WA), RT}; pg8::StaticOrder S; S.init(RT, 512, GD(), BX());
                  pg8::EpiBf16 E{(bf16*)(ws + OFF_CQKV), 512, nullptr, SSc, (const float*)(ws + OFF_BIAS) + BIAS_WA + (size_t)j * 17 * 512, (float*)(ws + OFF_STAT)};
                  pg8::gemm_phase<pg8::EpiBf16, pg8::StaticOrder, true, true>(lds, g, S, E); }
                GSYNC();
                { const float* RS4 = (const float*)(ws + OFF_STAT);
                  pg8::GemmT<1536, 256, 512> g{(const bf16*)(ws + OFF_CQKV), (const bf16*)(ws + OFF_WUQ + j * SZ_WUQ), rows_out}; pg8::StaticOrder S; S.init(rows_out, 1536, GD(), BX());
                  pg8::EpiBf16 E{(bf16*)(ws + OFF_Q), 1536, RS4, nullptr, nullptr, nullptr};
                  pg8::gemm_phase<pg8::EpiBf16, pg8::StaticOrder, true, true>(lds, g, S, E); }
                { const float* RS4 = (const float*)(ws + OFF_STAT);
                  pg8::GemmT<2048, 128, 512> g{(const bf16*)(ws + OFF_CQKV) + 256, (const bf16*)(ws + OFF_WUKV + j * SZ_WUKV), RT}; pg8::StaticOrder S; S.init(RT, 2048, GD(), BX());
                  pg8::EpiKV E{(bf16*)(ws + OFF_K), (bf16*)(ws + OFF_V), RS4};
                  pg8::gemm_phase<pg8::EpiKV, pg8::StaticOrder, true, true>(lds, g, S, E); }
                GSYNC();
#ifndef NO_FIN
                { finalize_phase((bf16*)(ws + OFF_Q), (bf16*)(ws + OFF_K), (const bf16*)(ws + OFF_CQKV), ldp(I_GQ) + j * 192, ldp(I_GK) + j * 192, (const float*)(ws + OFF_ROPE), false, GW, NGW_, lane); }
#endif
                GSYNC();
#ifndef NO_ATTN
                { const int G = GD(), bx = BX();
                  bf16* Qb = (bf16*)(ws + OFF_Q); const bf16* Kb = (const bf16*)(ws + OFF_K); const bf16* Vb = (const bf16*)(ws + OFF_V);
                  const int vcu = (G % 8 == 0) ? (bx % 8) * (G / 8) + bx / 8 : bx;
                  const int nunits = 1024 + (last ? 0 : 128); const float* gqp = ldp(I_GQ) + j * 192; const float* ropep = (const float*)(ws + OFF_ROPE);
                  for (int u = vcu; u < nunits; u += G) {
                      int b, h, q0, nt;
                      if (u < 1024) { b = u >> 6; h = (u >> 3) & 7; q0 = b * SEQ + (u & 7) * 256; nt = 36; }
                      else { b = (u - 1024) >> 3; h = (u - 1024) & 7; q0 = RL + b * CTXL; nt = 4; }
                      att::attn_unit(Qb, Kb, Vb, Qb, q0, h, nt, 4, RL + b * CTXL, b * SEQ, (char*)lds_raw, gqp, ropep, u < 1024);
                  } }
#endif
                GSYNC();
            }
            {
                const bool first = (itv == 0); const int m = l * 2 + (s >> 1);
                float* out = (float*)ldp_raw(I_OUT); float* hctx = (float*)(ws + OFF_HCTX);
                const int nx = itv + 1, ln = nx / 3, sn = nx - 3 * ln; const bool has_next = nx < 3 * DEPTH;
                const int half = (s != 1) ? 1 : 0;
                const bool split = (rows_out == RT) && (GD() == 256);
                float* part = (float*)(ws + OFF_BIG + ((s == 1 && kind == 0) ? 216 : 200) * MiB);
                const float* hin_c = first ? ldp(I_CTX) : hctx;
                const float* gatep = (const float*)(ws + OFF_MOD) + (size_t)l * NCOND * MODW + (3 * s + 2) * D;
                const float* scnp = (const float*)(ws + OFF_MOD) + (size_t)ln * NCOND * MODW + (3 * sn + 1) * D;
                const float* gnp = has_next ? ldp(I_GNORM) + (size_t)nx * D : nullptr;
#define MAKE_RES(NTF_) pg8::EpiRes E{first ? ldp(I_X) : out, hin_c, out, hctx, gatep, half, (bf16*)(ws + OFF_NH), (float*)(ws + OFF_SS), gnp, scnp, part, (NTF_) / 4}
#define RUN_RES(GT, AP, BP) do { GT g{AP, BP, rows_out}; MAKE_RES(GT::K / 64); \
                    if (split) { pg8::SplitCtxOrder S; S.init(RL, D, GD(), BX(), GT::K / 64); pg8::gemm_phase<pg8::EpiRes, pg8::SplitCtxOrder, true, true>(lds, g, S, E); } \
                    else { pg8::StaticOrder S; S.init(rows_out, D, GD(), BX()); pg8::gemm_phase<pg8::EpiRes, pg8::StaticOrder, true, true>(lds, g, S, E); } } while (0)
                if (s != 1) RUN_RES(GemmDn, (const bf16*)(ws + OFF_ACT), (const bf16*)(ws + OFF_WDN + m * SZ_WDN));
                else if (kind == 0) RUN_RES(GemmSq, (const bf16*)(ws + OFF_YY), (const bf16*)(ws + OFF_WOUT + j * SZ_SQ));
                else RUN_RES(GemmWo, (const bf16*)(ws + OFF_Q), (const bf16*)(ws + OFF_WO + j * SZ_WO));
#undef RUN_RES
#undef MAKE_RES
                if (split) {
                    GSYNC();
                    ctx_fix(hin_c, hctx, part, gatep + (size_t)16 * MODW, half ? 0.5f : 1.0f, (bf16*)(ws + OFF_NH), (float*)(ws + OFF_SS), gnp, scnp + (size_t)16 * MODW, GW, NGW_, lane);
                }
            }
            GSYNC();
        }
    }
}

extern "C" void kernel_launch(void* const* d_in, const int* in_sizes, int n_in, void* d_out, int out_size, void* d_ws, size_t ws_size, hipStream_t stream) {
    static int grid = 0;
    if (grid == 0) {
        if (n_in != N_IN || out_size != RL * D || ws_size < WS_END) { fprintf(stderr, "kernel_launch: unexpected shapes: n_in %d out %d ws %zu (need %zu)\n", n_in, out_size, ws_size, (size_t)WS_END); grid = -1; return; }
        int dev = 0, cus = 0, per_cu = 0;
        hipGetDevice(&dev); hipDeviceGetAttribute(&cus, hipDeviceAttributeMultiprocessorCount, dev);
        if (hipFuncSetAttribute((const void*)fwd_megakernel, hipFuncAttributeMaxDynamicSharedMemorySize, LDS_BYTES) != hipSuccess) { fprintf(stderr, "kernel_launch: hipFuncSetAttribute failed\n"); grid = -1; return; }
        if (hipOccupancyMaxActiveBlocksPerMultiprocessor(&per_cu, (const void*)fwd_megakernel, NWAVES * 64, LDS_BYTES) != hipSuccess || per_cu < 1) { fprintf(stderr, "kernel_launch: occupancy query says %d\n", per_cu); per_cu = 1; }
        (void)hipGetLastError();
        grid = cus * (per_cu > 1 ? 1 : per_cu);
        fprintf(stderr, "kernel_launch: grid %d (cus %d per_cu %d) ws %zu\n", grid, cus, per_cu, ws_size);
    }
    if (grid < 0) return;
    if (hipMemsetAsync((char*)d_ws + OFF_CTL, 0, CTL_BYTES, stream) != hipSuccess) { fprintf(stderr, "kernel_launch: memset failed\n"); return; }
    Params p{};
    for (int i = 0; i < N_IN; ++i) p.in[i] = (const float*)d_in[i];
    p.out = (float*)d_out; p.ws = (unsigned char*)d_ws; p.pad0 = 0; p.pad1 = 0;
    void* args[] = {&p};
    hipError_t e = hipLaunchCooperativeKernel((const void*)fwd_megakernel, dim3(grid), dim3(NWAVES * 64), args, LDS_BYTES, stream);
    if (e != hipSuccess) fprintf(stderr, "cooperative launch failed: %s (grid %d)\n", hipGetErrorString(e), grid);
}
```
